# Optimizing an MI355X kernel written in HIP

```python
import jax, jax.numpy as jnp
from jax import lax
import numpy as np

D_MODEL = 1024
BATCH = 16
SEQ = 4096
DEPTH = 4

N_META = 16
EPS = 1e-6
D_FF = 11 * D_MODEL // 4
BRANCH_W = D_MODEL // 2
N_BRANCH = 3
CONV_W = BRANCH_W
CONV_K = 3
ATT_HEAD_DIM = 64
ATT_HEADS = BRANCH_W // ATT_HEAD_DIM
ATT_KV_HEADS = 2
ATT_W = ATT_HEADS * ATT_HEAD_DIM
IDX_HEADS = 4
IDX_HEAD_DIM = ATT_HEAD_DIM
IDX_TOPK_MAX = 256
Q_BLOCK = 128
MLSTM_HEADS = 4
MLSTM_HEAD_DIM = BRANCH_W // MLSTM_HEADS
MLSTM_W = MLSTM_HEADS * MLSTM_HEAD_DIM
MLSTM_CHUNK = 64
ROPE_THETA = 10000.0

SPLIT_SIZES = (CONV_W, CONV_W, CONV_W,
               ATT_W, ATT_KV_HEADS * ATT_HEAD_DIM, ATT_KV_HEADS * ATT_HEAD_DIM,
               IDX_HEADS * IDX_HEAD_DIM, IDX_HEAD_DIM, IDX_HEADS,
               MLSTM_W, MLSTM_W, MLSTM_W, MLSTM_W, MLSTM_HEADS, MLSTM_HEADS,
               N_BRANCH * D_MODEL)
IN_W = sum(SPLIT_SIZES)

kernel_name = 'hybrid_conv_dsa_mlstm_macaron_trunk'


def rmsnorm(x, g):
    xf = x.astype(jnp.float32)
    y = xf * lax.rsqrt(jnp.mean(xf * xf, axis=-1, keepdims=True) + EPS)
    return (y * g).astype(x.dtype)


def headwise_rmsnorm(h, g):
    hf = h.astype(jnp.float32)
    y = hf * lax.rsqrt(jnp.mean(hf * hf, axis=-1, keepdims=True) + EPS)
    return (y.reshape(h.shape[:2] + (-1,)) * g).astype(h.dtype)


def swiglu(u, w_gu, w_down):
    gate, up = jnp.split(u @ w_gu, 2, axis=-1)
    return (jax.nn.silu(gate) * up) @ w_down


def rope_tables(T, dim):
    inv = 1.0 / (ROPE_THETA ** (jnp.arange(0, dim, 2, dtype=jnp.float32) / dim))
    ang = jnp.arange(T, dtype=jnp.float32)[:, None] * inv[None, :]
    return jnp.cos(ang), jnp.sin(ang)


def rope(x, cos, sin):
    xf = x.astype(jnp.float32)
    x1, x2 = jnp.split(xf, 2, axis=-1)
    c = cos[None, :, None, :]
    s = sin[None, :, None, :]
    return jnp.concatenate([x1 * c - x2 * s, x1 * s + x2 * c], axis=-1).astype(x.dtype)


def causal_dwconv(u, w):
    T = u.shape[1]
    up = jnp.pad(u, ((0, 0), (CONV_K - 1, 0), (0, 0)))
    out = w[0] * up[:, 0:T]
    for j in range(1, CONV_K):
        out = out + w[j] * up[:, j:j + T]
    return out


def indexed_sparse_attention(q, k, v, qi, ki, wi, topk):
    f32 = jnp.float32
    B, T = q.shape[:2]
    nblk = -(-T // Q_BLOCK)
    pad = nblk * Q_BLOCK - T

    def blocks(a):
        a = jnp.pad(a, [(0, 0), (0, pad)] + [(0, 0)] * (a.ndim - 2))
        return jnp.moveaxis(a.reshape((B, nblk, Q_BLOCK) + a.shape[2:]), 1, 0)

    starts = jnp.arange(nblk, dtype=jnp.int32) * Q_BLOCK
    key_pos = jnp.arange(T, dtype=jnp.int32)
    kif = ki.astype(f32)
    gather = jax.vmap(lambda a, i: a[i])

    def one_block(args):
        qb, qib, wib, start = args
        q_pos = start + jnp.arange(Q_BLOCK, dtype=jnp.int32)
        causal = key_pos[None, :] <= q_pos[:, None]
        rel = jax.nn.relu(jnp.einsum('bqhd,bsd->bqhs', qib.astype(f32), kif) * IDX_HEAD_DIM ** -0.5)
        score = jnp.einsum('bqh,bqhs->bqs', wib.astype(f32) * IDX_HEADS ** -0.5, rel)
        score = jnp.where(causal[None], score, -jnp.inf)
        top_val, top_idx = lax.top_k(score, topk)
        valid = top_val > -jnp.inf
        k_sel = gather(k, top_idx)
        v_sel = gather(v, top_idx)
        qg = qb.reshape(B, Q_BLOCK, ATT_KV_HEADS, ATT_HEADS // ATT_KV_HEADS, ATT_HEAD_DIM)
        s = jnp.einsum('bqgrd,bqkgd->bqgrk', qg, k_sel).astype(f32) * ATT_HEAD_DIM ** -0.5
        s = jnp.where(valid[:, :, None, None, :], s, -jnp.inf)
        p = jax.nn.softmax(s, axis=-1).astype(v.dtype)
        o = jnp.einsum('bqgrk,bqkgd->bqgrd', p, v_sel)
        return o.reshape(B, Q_BLOCK, ATT_W)

    out = lax.map(one_block, (blocks(q), blocks(qi), blocks(wi), starts))
    return jnp.moveaxis(out, 0, 1).reshape(B, nblk * Q_BLOCK, ATT_W)[:, :T].astype(q.dtype)


def mlstm_chunkwise(q, k, v, i_pre, f_pre):
    f32 = jnp.float32
    B, T, H, Dh = q.shape
    L = MLSTM_CHUNK
    pad = (-N_META) % L

    def seq_chunks(a):
        a = jnp.pad(a.astype(f32), ((0, 0), (pad, 0), (0, 0), (0, 0)))
        return jnp.transpose(a.reshape(B, -1, L, H, Dh), (1, 0, 3, 2, 4))

    def gate_chunks(a, fill):
        a = jnp.pad(a, ((0, 0), (pad, 0), (0, 0)), constant_values=fill)
        return jnp.transpose(a.reshape(B, -1, L, H), (1, 0, 3, 2))

    qs = seq_chunks(q)
    ks = seq_chunks(k) * Dh ** -0.5
    vs = seq_chunks(v)
    logi = gate_chunks(i_pre.astype(f32), -jnp.inf)
    logf = gate_chunks(jax.nn.log_sigmoid(f_pre.astype(f32)), 0.0)
    tril = jnp.tril(jnp.ones((L, L), dtype=bool))

    def step(carry, xs):
        C, n, m = carry
        qc, kc, vc, ic, fc = xs
        b = jnp.cumsum(fc, axis=-1)
        bL = b[..., -1]
        Dm = jnp.where(tril, b[..., :, None] - b[..., None, :] + ic[..., None, :], -jnp.inf)
        a = b + m[..., None]
        mq = jnp.maximum(a, Dm.max(axis=-1))
        inter = jnp.exp(a - mq)
        wqk = jnp.exp(Dm - mq[..., None]) * jnp.einsum('bhld,bhsd->bhls', qc, kc)
        num = inter[..., None] * jnp.einsum('bhld,bhde->bhle', qc, C) + jnp.einsum('bhls,bhse->bhle', wqk, vc)
        den = inter * jnp.einsum('bhld,bhd->bhl', qc, n) + wqk.sum(axis=-1)
        hc = num / jnp.maximum(jnp.abs(den), jnp.exp(-mq))[..., None]
        g = bL[..., None] - b + ic
        m_new = jnp.maximum(bL + m, g.max(axis=-1))
        decay = jnp.exp(bL + m - m_new)
        wk = jnp.exp(g - m_new[..., None])[..., None] * kc
        C_new = decay[..., None, None] * C + jnp.einsum('bhld,bhle->bhde', wk, vc)
        n_new = decay[..., None] * n + wk.sum(axis=-2)
        return (C_new, n_new, m_new), hc

    init = (jnp.zeros((B, H, Dh, Dh), f32), jnp.zeros((B, H, Dh), f32), jnp.zeros((B, H), f32))
    _, hs = lax.scan(step, init, (qs, ks, vs, logi, logf))
    hs = jnp.transpose(hs, (1, 0, 3, 2, 4)).reshape(B, -1, H, Dh)[:, pad:]
    return hs.astype(q.dtype)


def hybrid_mixer(u, w_in, w_conv, b_igate, b_fgate, mh_g, w_branch, w_out, cos, sin, topk):
    B, T, _ = u.shape
    offs = [int(o) for o in np.cumsum(SPLIT_SIZES)[:-1]]
    (cx, cb, cc, q, k, v, qi, ki, wi, mq, mk, mv, mo, mi, mf, gt) = jnp.split(u @ w_in, offs, axis=-1)
    y_a = cb * causal_dwconv(cc * cx, w_conv)
    q = rope(q.reshape(B, T, ATT_HEADS, ATT_HEAD_DIM), cos, sin)
    k = rope(k.reshape(B, T, ATT_KV_HEADS, ATT_HEAD_DIM), cos, sin)
    v = v.reshape(B, T, ATT_KV_HEADS, ATT_HEAD_DIM)
    qi = rope(qi.reshape(B, T, IDX_HEADS, IDX_HEAD_DIM), cos, sin)
    ki = rope(ki[:, :, None, :], cos, sin)[:, :, 0, :]
    y_b = indexed_sparse_attention(q, k, v, qi, ki, wi, topk)
    hm = mlstm_chunkwise(mq.reshape(B, T, MLSTM_HEADS, MLSTM_HEAD_DIM),
                         mk.reshape(B, T, MLSTM_HEADS, MLSTM_HEAD_DIM),
                         mv.reshape(B, T, MLSTM_HEADS, MLSTM_HEAD_DIM),
                         mi + b_igate, mf + b_fgate)
    y_c = headwise_rmsnorm(hm, mh_g) * jax.nn.sigmoid(mo)
    gates = jax.nn.sigmoid(gt.reshape(B, T, N_BRANCH, D_MODEL))
    merged = (gates[:, :, 0] * (y_a @ w_branch[0])
              + gates[:, :, 1] * (y_b @ w_branch[1])
              + gates[:, :, 2] * (y_c @ w_branch[2]))
    return merged @ w_out


def setup_inputs(seed: int = 0) -> dict:
    key = jax.random.key(seed)
    ks = jax.random.split(key, 12)
    f32 = jnp.float32

    def nrm(k, shape, scale):
        return jax.random.normal(k, shape, f32) * scale

    x = nrm(ks[0], (BATCH, SEQ, D_MODEL), 1.0)
    meta = nrm(ks[1], (N_META, D_MODEL), 1.0)
    norm_g = 1.0 + nrm(ks[2], (DEPTH, 6, D_MODEL), 0.02)
    w_ffn_gu = nrm(ks[3], (DEPTH, 2, D_MODEL, 2 * D_FF), D_MODEL ** -0.5)
    w_ffn_down = nrm(ks[4], (DEPTH, 2, D_FF, D_MODEL), D_FF ** -0.5)
    w_in = nrm(ks[5], (DEPTH, D_MODEL, IN_W), D_MODEL ** -0.5)
    w_conv = nrm(ks[6], (DEPTH, CONV_K, CONV_W), CONV_K ** -0.5)
    b_igate = nrm(ks[7], (DEPTH, MLSTM_HEADS), 0.1)
    b_fgate = jnp.linspace(3.0, 6.0, MLSTM_HEADS, dtype=f32)[None, :] + nrm(ks[8], (DEPTH, MLSTM_HEADS), 0.1)
    mh_norm_g = 1.0 + nrm(ks[9], (DEPTH, MLSTM_W), 0.02)
    w_branch = nrm(ks[10], (DEPTH, N_BRANCH, BRANCH_W, D_MODEL), BRANCH_W ** -0.5)
    w_out = nrm(ks[11], (DEPTH, D_MODEL, D_MODEL), D_MODEL ** -0.5)
    return {'x': x, 'meta': meta, 'norm_g': norm_g, 'w_ffn_gu': w_ffn_gu, 'w_ffn_down': w_ffn_down,
            'w_in': w_in, 'w_conv': w_conv, 'b_igate': b_igate, 'b_fgate': b_fgate,
            'mh_norm_g': mh_norm_g, 'w_branch': w_branch, 'w_out': w_out}


def reference(x, meta, norm_g, w_ffn_gu, w_ffn_down, w_in, w_conv, b_igate, b_fgate, mh_norm_g, w_branch, w_out):
    B, S, _ = x.shape
    h = jnp.concatenate([jnp.broadcast_to(meta.astype(x.dtype)[None], (B, N_META, D_MODEL)), x], axis=1)
    T = h.shape[1]
    cos, sin = rope_tables(T, ATT_HEAD_DIM)
    topk = min(IDX_TOPK_MAX, S // 4)
    for l in range(DEPTH):
        g = norm_g[l]
        h = h + 0.5 * rmsnorm(swiglu(rmsnorm(h, g[0]), w_ffn_gu[l, 0], w_ffn_down[l, 0]), g[1])
        y = hybrid_mixer(rmsnorm(h, g[2]), w_in[l], w_conv[l], b_igate[l], b_fgate[l], mh_norm_g[l],
                         w_branch[l], w_out[l], cos, sin, topk)
        h = h + rmsnorm(y, g[3])
        h = h + 0.5 * rmsnorm(swiglu(rmsnorm(h, g[4]), w_ffn_gu[l, 1], w_ffn_down[l, 1]), g[5])
    return h[:, N_META:]
```

```cpp
#include <hip/hip_runtime.h>
#include <cstdio>
#include <cstdint>

#define LAS __attribute__((address_space(3)))
typedef unsigned short bf16_t;
typedef short bf16x8 __attribute__((ext_vector_type(8)));
typedef short bf16x4 __attribute__((ext_vector_type(4)));
typedef float f32x4 __attribute__((ext_vector_type(4)));
typedef float f32x2 __attribute__((ext_vector_type(2)));
typedef unsigned u32x4 __attribute__((ext_vector_type(4)));
typedef unsigned u32x2 __attribute__((ext_vector_type(2)));

#ifndef DBG_STOP
#define DBG_STOP 1000
#endif

constexpr int BATCH = 16, SEQ = 4096, DM = 1024, DEPTH = 4, NMETA = 16;
constexpr int T = SEQ + NMETA;
constexpr int M = BATCH * T;
constexpr int DFF = 2816, NGU = 2 * DFF;
constexpr int INW = 7756, LDP = 7936;
constexpr int HBAT = 8;
constexpr int MH = HBAT * T;
constexpr int MHP = 129 * 256;
constexpr float EPS = 1e-6f;
constexpr int PC_CX = 0, PC_CB = 512, PC_CC = 1024, PC_Q = 1536, PC_QI = 2304, PC_WI = 2624, PC_MI = 2628, PC_MF = 2632;
constexpr int PC_MQ = 2816, PC_MK = 3328, PC_MV = 3840, PC_MO = 4352, PC_GT = 4864;
constexpr int SC_Q = 1536, SC_K = 2048, SC_V = 2176, SC_QI = 2304, SC_KI = 2560, SC_WI = 2624, SC_MQ = 2628, SC_MI = 4676, SC_MF = 4680, SC_GT = 4684;

constexpr size_t MiB = 1u << 20;
constexpr size_t WS_CTL = 0, CTL_ZERO_BYTES = 1 * MiB;
constexpr size_t WS_COS = 1 * MiB, WS_SIN = 2 * MiB;
constexpr size_t WS_WGU0 = 8 * MiB, WS_WGU1 = 19 * MiB, WS_WDN0 = 30 * MiB, WS_WDN1 = 36 * MiB, WS_WIN = 42 * MiB, WS_WBR = 58 * MiB, WS_WOUT = 61 * MiB;
constexpr size_t WS_H = 72 * MiB;
constexpr size_t WS_Y = 329 * MiB;
constexpr size_t WS_BIG = 458 * MiB;
constexpr size_t WS_KV = 958 * MiB;
constexpr size_t WS_KI = 975 * MiB;
constexpr size_t WS_END = 980 * MiB;
static_assert(WS_BIG + (size_t)MHP * LDP * 2 <= WS_KV && WS_KV + (size_t)MHP * 512 <= WS_KI && WS_KI + (size_t)MHP * 128 <= WS_END, "ws map");
static_assert(WS_H + (size_t)M * DM * 4 <= WS_Y && WS_Y + (size_t)(M + 128) * DM * 2 <= WS_BIG && WS_BIG + (size_t)M * DFF * 2 <= WS_KV, "ws map 2");
constexpr int CW_BAR = 4096;
constexpr int CW_QUEUE = 16384;

constexpr int RING_BYTES = 131072;
constexpr int LDSCTL_OFF = RING_BYTES;
constexpr int LDS_BYTES = RING_BYTES + 8192;

__device__ __forceinline__ float bf_lo(unsigned w) { return __uint_as_float(w << 16); }
__device__ __forceinline__ float bf_hi(unsigned w) { return __uint_as_float(w & 0xffff0000u); }
__device__ __forceinline__ float bf2f(bf16_t b) { return __uint_as_float(((unsigned)b) << 16); }
__device__ __forceinline__ unsigned cvt_pk_bf16(float lo, float hi) { unsigned r; asm volatile("v_cvt_pk_bf16_f32 %0, %1, %2" : "=v"(r) : "v"(lo), "v"(hi)); return r; }
__device__ __forceinline__ float wave_sum(float v) {
#pragma unroll
    for (int o = 1; o < 64; o <<= 1) v += __shfl_xor(v, o);
    return v;
}
__device__ __forceinline__ float fast_exp(float x) { return __builtin_amdgcn_exp2f(x * 1.44269504089f); }
__device__ __forceinline__ float sigmoidf_(float x) { return __builtin_amdgcn_rcpf(1.0f + fast_exp(-x)); }

namespace pg8 {
constexpr int BM = 256, BK = 64, HALF = 128, HTB = HALF * BK * 2, STAGE_BYTES = 8 * HTB, NXCD = 8, WGM = 8;
__host__ __device__ __forceinline__ int lds_byte(int r, int c) { const int st = (r >> 4) * 2 + (c >> 5), rr = r & 15, cc = c & 31, ob = rr * 64 + cc * 2; return st * 1024 + (ob ^ (((ob >> 9) & 1) << 5)); }
__host__ __device__ __forceinline__ void stage_rc(int b, int& R, int& C) { const int st = b / 1024, sb = b % 1024, swz = sb ^ (((sb >> 9) & 1) << 5); R = (st >> 1) * 16 + swz / 64; C = (st & 1) * 32 + (swz % 64) / 2; }
__host__ __device__ __forceinline__ int perm32(int rho) { const int n = rho >> 4, i = rho & 15; return 8 * (i >> 2) + 4 * n + (i & 3); }

struct Unit { int pm, pn, z; };
struct Gemm { const char* A0; const char* A1; const char* A2; const char* Bt; size_t bzs; int lda, ldb, K;
    __device__ __forceinline__ const char* abase(int z) const { return z == 0 ? A0 : (z == 1 ? A1 : A2); } };
struct Sched {
    int nM, nN, nZ, nwg, G, c;
    __device__ __forceinline__ void init(int nM_, int nN_, int nZ_, int G_, int c_) { nM = nM_; nN = nN_; nZ = nZ_; nwg = nM * nN; G = G_; c = c_; }
    __device__ __forceinline__ bool next(int i, Unit& u) const {
        const int ti = i / nZ; u.z = i - ti * nZ;
        const long L = (long)ti * G + c; if (L >= nwg) return false;
        int wgid = (int)L; { const int q = nwg / NXCD, r = nwg % NXCD, xcd = wgid % NXCD, off = wgid / NXCD; wgid = (xcd < r ? xcd * (q + 1) : r * (q + 1) + (xcd - r) * q) + off; }
        const int nig = WGM * nN, gid = wgid / nig, fm = gid * WGM, gsz = (nM - fm) < WGM ? (nM - fm) : WGM;
        u.pm = fm + ((wgid % nig) % gsz); u.pn = (wgid % nig) / gsz; return true;
    }
};

template <class Epi>
__device__ __forceinline__ void gemm_phase(LAS unsigned char* lds, const Gemm g, const Sched& S, const Epi& E) {
    int tid_ = threadIdx.x; asm volatile("" : "+v"(tid_));
    const int tid = tid_, wid = __builtin_amdgcn_readfirstlane(tid >> 6), lane = tid & 63, wr = wid >> 2, wc = wid & 3, fr = lane & 15, fq = lane >> 4;
    const int K = g.K, nt = K / BK;
    unsigned voffA[2], voffB[2];
#pragma unroll
    for (int i = 0; i < 2; ++i) { int R, C; stage_rc(tid * 16 + i * 8192, R, C); const int Rb = (R & ~31) + perm32(R & 31);
        voffA[i] = (unsigned)(R * g.lda + C) * 2u; voffB[i] = (unsigned)(Rb * g.ldb + C) * 2u; }
    const size_t kstep = (size_t)(BK * 2);
    const size_t hstepA = (size_t)HALF * g.lda * 2, hstepB = (size_t)HALF * g.ldb * 2;
    const size_t tstepA = 2 * hstepA, tstepB = 2 * hstepB;
    const unsigned ldsw = (unsigned)wid * 1024u;
    const int aoff = lds_byte(wr * 64 + fr, fq * 8), boff = lds_byte(wc * 32 + fr, fq * 8);
#define PG8_SA(b, h) (((b) * 2 + (h)) * HTB)
#define PG8_SB(b, h) ((4 + (b) * 2 + (h)) * HTB)
#define PG8_STAGE(bufoff, gbase, voff) do { _Pragma("unroll") for (int _i = 0; _i < 2; ++_i) \
        __builtin_amdgcn_global_load_lds((const unsigned*)((const char*)(gbase) + (voff)[_i]), (LAS unsigned*)(lds + (bufoff) + ldsw + _i * 8192), 16, 0, 0); } while (0)
#define PG8_LDA(dst, b, h) do { _Pragma("unroll") for (int m = 0; m < 4; ++m) _Pragma("unroll") for (int k = 0; k < 2; ++k) dst[m][k] = *(const LAS bf16x8*)(lds + PG8_SA(b, h) + aoff + m * 2048 + k * 1024); } while (0)
#define PG8_LDB(dst, b, h) do { _Pragma("unroll") for (int n = 0; n < 2; ++n) _Pragma("unroll") for (int k = 0; k < 2; ++k) dst[n][k] = *(const LAS bf16x8*)(lds + PG8_SB(b, h) + boff + n * 2048 + k * 1024); } while (0)
#define PG8_MMA(ai, bj, At, Bt) do { __builtin_amdgcn_s_setprio(1); _Pragma("unroll") for (int m = 0; m < 4; ++m) _Pragma("unroll") for (int n = 0; n < 2; ++n) _Pragma("unroll") for (int k = 0; k < 2; ++k) \
        acc[ai][bj][m][n] = __builtin_amdgcn_mfma_f32_16x16x32_bf16(Bt[n][k], At[m][k], acc[ai][bj][m][n], 0, 0, 0); __builtin_amdgcn_s_setprio(0); } while (0)
#define PG8_WAIT_V(n) asm volatile("s_waitcnt vmcnt(" #n ")" ::: "memory")
#define PG8_WAIT_L(n) asm volatile("s_waitcnt lgkmcnt(" #n ")" ::: "memory")
#define PG8_BAR __builtin_amdgcn_s_barrier()
#define PG8_SCHED __builtin_amdgcn_sched_barrier(0)
    Unit cur, nxt; int ui = 0;
    if (!S.next(0, cur)) return;
    f32x4 acc[2][2][4][2];
#pragma unroll
    for (int a = 0; a < 2; ++a)
#pragma unroll
        for (int b = 0; b < 2; ++b)
#pragma unroll
            for (int m = 0; m < 4; ++m)
#pragma unroll
                for (int n = 0; n < 2; ++n) acc[a][b][m][n] = (f32x4){0.f, 0.f, 0.f, 0.f};
    bf16x8 At[4][2], B0[2][2], B1[2][2];
    const char* cA = g.abase(cur.z) + (size_t)cur.pm * tstepA; const char* cB = g.Bt + (size_t)cur.z * g.bzs + (size_t)cur.pn * tstepB;
    PG8_STAGE(PG8_SB(0, 0), cB, voffB); PG8_STAGE(PG8_SA(0, 0), cA, voffA); PG8_STAGE(PG8_SB(0, 1), cB + hstepB, voffB); PG8_STAGE(PG8_SA(0, 1), cA + hstepA, voffA);
    if (wr == 1) PG8_BAR;
    PG8_WAIT_V(4); PG8_BAR;
    PG8_STAGE(PG8_SB(1, 0), cB + kstep, voffB); PG8_STAGE(PG8_SA(1, 0), cA + kstep, voffA); PG8_STAGE(PG8_SB(1, 1), cB + hstepB + kstep, voffB);
    PG8_WAIT_V(6); PG8_BAR;
    for (;;) {
        const bool has_next = S.next(ui + 1, nxt);
        const char* nA = has_next ? g.abase(nxt.z) + (size_t)nxt.pm * tstepA : cA; const char* nB = has_next ? g.Bt + (size_t)nxt.z * g.bzs + (size_t)nxt.pn * tstepB : cB;
        for (int t = 0; t < nt; t += 2) {
            const bool last = (t == nt - 2);
            const char* a1 = cA + (size_t)(t + 1) * kstep;
            const char* a2 = last ? nA : cA + (size_t)(t + 2) * kstep; const char* b2 = last ? nB : cB + (size_t)(t + 2) * kstep;
            const char* a3 = a2 + kstep; const char* b3 = b2 + kstep;
            PG8_LDB(B0, 0, 0); PG8_SCHED; PG8_LDA(At, 0, 0); PG8_STAGE(PG8_SA(1, 1), a1 + hstepA, voffA);
            PG8_WAIT_L(8); PG8_BAR; PG8_WAIT_L(0); PG8_MMA(0, 0, At, B0); PG8_BAR; PG8_SCHED;
            PG8_LDB(B1, 0, 1); PG8_STAGE(PG8_SB(0, 0), b2, voffB);
            PG8_BAR; PG8_WAIT_L(0); PG8_MMA(0, 1, At, B1); PG8_BAR;
            PG8_LDA(At, 0, 1); PG8_STAGE(PG8_SA(0, 0), a2, voffA);
            PG8_BAR; PG8_WAIT_L(0); PG8_MMA(1, 0, At, B0); PG8_BAR; PG8_SCHED;
            PG8_STAGE(PG8_SB(0, 1), b2 + hstepB, voffB);
            PG8_WAIT_V(6); PG8_BAR; PG8_MMA(1, 1, At, B1); PG8_BAR;
            PG8_LDB(B0, 1, 0); PG8_SCHED; PG8_LDA(At, 1, 0); PG8_STAGE(PG8_SA(0, 1), a2 + hstepA, voffA);
            PG8_WAIT_L(8); PG8_BAR; PG8_WAIT_L(0); PG8_MMA(0, 0, At, B0); PG8_BAR; PG8_SCHED;
            PG8_LDB(B1, 1, 1); PG8_STAGE(PG8_SB(1, 0), b3, voffB);
            PG8_BAR; PG8_WAIT_L(0); PG8_MMA(0, 1, At, B1); PG8_BAR;
            PG8_LDA(At, 1, 1); PG8_STAGE(PG8_SA(1, 0), a3, voffA);
            PG8_BAR; PG8_WAIT_L(0); PG8_MMA(1, 0, At, B0); PG8_BAR; PG8_SCHED;
            PG8_STAGE(PG8_SB(1, 1), b3 + hstepB, voffB);
            PG8_WAIT_V(6); PG8_BAR; PG8_MMA(1, 1, At, B1); PG8_BAR;
        }
        const bool zero = E(acc, cur, wr, wc, fr, fq);
        if (!has_next) break;
        if (zero) {
#pragma unroll
            for (int a = 0; a < 2; ++a)
#pragma unroll
                for (int b = 0; b < 2; ++b)
#pragma unroll
                    for (int m = 0; m < 4; ++m)
#pragma unroll
                        for (int n = 0; n < 2; ++n) acc[a][b][m][n] = (f32x4){0.f, 0.f, 0.f, 0.f};
        }
        cur = nxt; cA = nA; cB = nB; ++ui;
    }
    PG8_WAIT_V(0);
    if (wr == 0) PG8_BAR;
    PG8_BAR;
#undef PG8_SA
#undef PG8_SB
#undef PG8_STAGE
#undef PG8_LDA
#undef PG8_LDB
#undef PG8_MMA
#undef PG8_WAIT_V
#undef PG8_WAIT_L
#undef PG8_BAR
#undef PG8_SCHED
}

__device__ __forceinline__ u32x4 pack8(const f32x4 a, const f32x4 b) { u32x4 w; w.x = cvt_pk_bf16(a[0], a[1]); w.y = cvt_pk_bf16(a[2], a[3]); w.z = cvt_pk_bf16(b[0], b[1]); w.w = cvt_pk_bf16(b[2], b[3]); return w; }

struct EpiBf16 {
    bf16_t* O; int ldc;
    __device__ __forceinline__ bool operator()(f32x4 (&acc)[2][2][4][2], const Unit& u, int wr, int wc, int fr, int fq) const {
        const int row0 = u.pm * BM + wr * 64 + fr, col0 = u.pn * BM + wc * 32 + 8 * fq;
#pragma unroll
        for (int ai = 0; ai < 2; ++ai)
#pragma unroll
            for (int m = 0; m < 4; ++m) { bf16_t* rowp = O + (size_t)(row0 + ai * HALF + m * 16) * ldc + col0;
#pragma unroll
                for (int bj = 0; bj < 2; ++bj) *(u32x4*)(rowp + bj * HALF) = pack8(acc[ai][bj][m][0], acc[ai][bj][m][1]); }
        return true;
    }
};
struct EpiSwiglu {
    bf16_t* O; int ldc;
    __device__ __forceinline__ bool operator()(f32x4 (&acc)[2][2][4][2], const Unit& u, int wr, int wc, int fr, int fq) const {
        const int row0 = u.pm * BM + wr * 64 + fr, col0 = u.pn * HALF + wc * 32 + 8 * fq;
#pragma unroll
        for (int ai = 0; ai < 2; ++ai)
#pragma unroll
            for (int m = 0; m < 4; ++m) { bf16_t* rowp = O + (size_t)(row0 + ai * HALF + m * 16) * ldc + col0;
                f32x4 o[2];
#pragma unroll
                for (int n = 0; n < 2; ++n)
#pragma unroll
                    for (int j = 0; j < 4; ++j) { const float gt = acc[ai][0][m][n][j], up = acc[ai][1][m][n][j]; o[n][j] = gt * sigmoidf_(gt) * up; }
                *(u32x4*)rowp = pack8(o[0], o[1]); }
        return true;
    }
};
struct EpiWin {
    bf16_t* P; bf16_t* KV; bf16_t* KI; const float* ctab; const float* stab;
    __device__ __forceinline__ bool operator()(f32x4 (&acc)[2][2][4][2], const Unit& u, int wr, int wc, int fr, int fq) const {
        const int row0 = u.pm * BM + wr * 64 + fr; const int pn = u.pn;
        const bool rope_tile = (pn >= 6 && pn <= 10);
        if (!rope_tile) {
            const int col0 = pn * BM + wc * 32 + 8 * fq;
#pragma unroll
            for (int ai = 0; ai < 2; ++ai)
#pragma unroll
                for (int m = 0; m < 4; ++m) { bf16_t* rowp = P + (size_t)(row0 + ai * HALF + m * 16) * LDP + col0;
#pragma unroll
                    for (int bj = 0; bj < 2; ++bj) *(u32x4*)(rowp + bj * HALF) = pack8(acc[ai][bj][m][0], acc[ai][bj][m][1]); }
            return true;
        }
        bool do_rope = true, skip = false; bf16_t* dbase; int dld, dcol;
        if (pn == 6 || pn == 7) { dbase = P; dld = LDP; dcol = PC_Q + (4 * (pn - 6) + wc) * 64; }
        else if (pn == 8) { dbase = KV; dld = 256; if (wc < 2) dcol = wc * 64; else { dcol = 128 + (wc - 2) * 64; do_rope = false; } }
        else if (pn == 9) { dbase = P; dld = LDP; dcol = PC_QI + wc * 64; }
        else { if (wc == 0) { dbase = KI; dld = 64; dcol = 0; } else if (wc == 1) { dbase = P; dld = LDP; dcol = PC_WI; do_rope = false; } else { dbase = P; dld = LDP; dcol = 0; skip = true; } }
        if (skip) return true;
#pragma unroll
        for (int ai = 0; ai < 2; ++ai)
#pragma unroll
            for (int m = 0; m < 4; ++m) {
                const int rl = row0 + ai * HALF + m * 16; const int t = rl % T;
                bf16_t* dp = dbase + (size_t)rl * dld + dcol + 8 * fq;
                f32x4 x1a = acc[ai][0][m][0], x1b = acc[ai][0][m][1], x2a = acc[ai][1][m][0], x2b = acc[ai][1][m][1];
                if (do_rope) {
                    const float* cp = ctab + t * 32 + 8 * fq; const float* sp = stab + t * 32 + 8 * fq;
                    const f32x4 c0 = *(const f32x4*)cp, c1 = *(const f32x4*)(cp + 4), s0 = *(const f32x4*)sp, s1 = *(const f32x4*)(sp + 4);
                    const f32x4 o1a = x1a * c0 - x2a * s0, o1b = x1b * c1 - x2b * s1, o2a = x1a * s0 + x2a * c0, o2b = x1b * s1 + x2b * c1;
                    *(u32x4*)dp = pack8(o1a, o1b); *(u32x4*)(dp + 32) = pack8(o2a, o2b);
                } else if (pn == 8) {
                    *(u32x4*)dp = pack8(x1a, x1b); *(u32x4*)(dp + 32) = pack8(x2a, x2b);
                } else {
                    *(u32x4*)dp = pack8(x1a, x1b);
                }
            }
        return true;
    }
};
struct EpiMerge {
    const bf16_t* P; bf16_t* O;
    __device__ __forceinline__ float eneg(float x) const { x = fminf(fmaxf(x, -60.f), 60.f); return 1.0f + fast_exp(-x); }
    __device__ __forceinline__ bool operator()(f32x4 (&acc)[2][2][4][2], const Unit& u, int wr, int wc, int fr, int fq) const {
        const int row0 = u.pm * BM + wr * 64 + fr, col0 = u.pn * BM + wc * 32 + 8 * fq; const int z = u.z;
#pragma unroll
        for (int ai = 0; ai < 2; ++ai)
#pragma unroll
            for (int m = 0; m < 4; ++m) { const size_t rl = (size_t)(row0 + ai * HALF + m * 16);
                const bf16_t* gp = P + rl * LDP + PC_GT + z * DM + col0;
#pragma unroll
                for (int bj = 0; bj < 2; ++bj) {
                    const u32x4 gz = *(const u32x4*)(gp + bj * HALF);
                    float f[8];
                    if (z < 2) { const u32x4 gn = *(const u32x4*)(gp + DM + bj * HALF);
#pragma unroll
                        for (int j = 0; j < 4; ++j) { f[2 * j] = eneg(bf_lo(gn[j])) * __builtin_amdgcn_rcpf(eneg(bf_lo(gz[j]))); f[2 * j + 1] = eneg(bf_hi(gn[j])) * __builtin_amdgcn_rcpf(eneg(bf_hi(gz[j]))); }
                    } else {
#pragma unroll
                        for (int j = 0; j < 4; ++j) { f[2 * j] = __builtin_amdgcn_rcpf(eneg(bf_lo(gz[j]))); f[2 * j + 1] = __builtin_amdgcn_rcpf(eneg(bf_hi(gz[j]))); }
                    }
#pragma unroll
                    for (int j = 0; j < 4; ++j) { acc[ai][bj][m][0][j] *= f[j]; acc[ai][bj][m][1][j] *= f[4 + j]; }
                    if (z == 2) *(u32x4*)(O + rl * DM + col0 + bj * HALF) = pack8(acc[ai][bj][m][0], acc[ai][bj][m][1]);
                } }
        return z == 2;
    }
};
}

#define XB_TMO      128
#define XB_XCNT(j)  (256  + 64 * (j))
#define XB_XSUB(j)  (1280 + 64 * (j))
#define XB_XGEN(j)  (2304 + 64 * (j))
#define XB_TOP      3328
#define XB_TOPGEN   3392
#define XCD_BAR_WORDS 3456
#define XB_SPIN_CAP (1u << 22)
__device__ __forceinline__ unsigned xb_ld(unsigned* p)              { return __hip_atomic_load(p, __ATOMIC_RELAXED, __HIP_MEMORY_SCOPE_AGENT); }
__device__ __forceinline__ unsigned xb_add(unsigned* p, unsigned v) { return __hip_atomic_fetch_add(p, v, __ATOMIC_RELAXED, __HIP_MEMORY_SCOPE_AGENT); }
__device__ __forceinline__ unsigned xb_xcc_id() { return (unsigned)__builtin_amdgcn_s_getreg((3 << 11) | 20) & 0xFu; }
#define XB_SPIN(cond, bar) do { unsigned _sp = 0; while (cond) { __builtin_amdgcn_s_sleep(1); \
    if ((++_sp & 255u) == 0u) { if (xb_ld(&(bar)[XB_TMO])) break; if (_sp > XB_SPIN_CAP) { atomicAdd(&(bar)[XB_TMO], 1u); break; } } } } while (0)
struct XcdBarrier { unsigned* bar; unsigned x; volatile LAS unsigned* st; };
__device__ __forceinline__ XcdBarrier xcd_barrier_post(unsigned* bar, volatile LAS unsigned* st) {
    XcdBarrier b; b.bar = bar; b.x = xb_xcc_id(); b.st = st;
    if (threadIdx.x == 0) (void)xb_add(&bar[XB_XCNT(b.x)], 1u);
    return b;
}
__device__ __forceinline__ void xcd_barrier_complete(unsigned* bar, unsigned x, unsigned& nloc, unsigned& nx) {
    const unsigned G = gridDim.x * gridDim.y * gridDim.z;
    unsigned sum, cnt, mine, sp = 0u;
    for (;;) {
        sum = 0u; cnt = 0u; mine = 0u;
#pragma unroll
        for (unsigned j = 0; j < 16; ++j) { const unsigned c = xb_ld(&bar[XB_XCNT(j)]); sum += c; cnt += (c > 0u) ? 1u : 0u; mine = (j == x) ? c : mine; }
        if (sum == G) break;
        __builtin_amdgcn_s_sleep(1);
        if ((++sp & 255u) == 0u) { if (xb_ld(&bar[XB_TMO])) break; if (sp > XB_SPIN_CAP) { atomicAdd(&bar[XB_TMO], 1u); break; } }
    }
    nloc = mine > 0u ? mine : 1u; nx = cnt > 0u ? cnt : 1u;
}
__device__ __forceinline__ void xcd_barrier(const XcdBarrier& b) {
    asm volatile("s_waitcnt vmcnt(0)" ::: "memory");
    __syncthreads();
    if (threadIdx.x == 0) {
        unsigned* bar = b.bar;
        __builtin_amdgcn_s_waitcnt(0);
        unsigned nloc = b.st[0], nx = b.st[1];
        if (nloc == 0u) { xcd_barrier_complete(bar, b.x, nloc, nx); b.st[0] = nloc; b.st[1] = nx; }
        const unsigned old = xb_add(&bar[XB_XSUB(b.x)], 1u);
        const unsigned gen = old / nloc;
        if (old + 1u == (gen + 1u) * nloc) {
            __builtin_amdgcn_fence(__ATOMIC_RELEASE, "agent");
            asm volatile("s_waitcnt vmcnt(0)" ::: "memory");
            const unsigned og = xb_add(&bar[XB_TOP], 1u);
            const unsigned tg = og / nx;
            if (og + 1u == (tg + 1u) * nx) xb_add(&bar[XB_TOPGEN], 1u);
            else XB_SPIN(xb_ld(&bar[XB_TOPGEN]) == tg, bar);
            __builtin_amdgcn_fence(__ATOMIC_ACQUIRE, "agent");
            xb_add(&bar[XB_XGEN(b.x)], 1u);
            asm volatile("s_waitcnt vmcnt(0)" ::: "memory");
        } else {
            XB_SPIN(xb_ld(&bar[XB_XGEN(b.x)]) == gen, bar);
            __builtin_amdgcn_fence(__ATOMIC_ACQUIRE, "agent");
            asm volatile("s_waitcnt vmcnt(0)" ::: "memory");
        }
    }
    __syncthreads();
}

template <class Map>
__device__ __forceinline__ void cvt_item(const float* W, int K, int N, bf16_t* WT, LAS float* scr, int item, int lane, Map srccol) {
    asm volatile("" : "+v"(lane));
    const int nkb = K / 64, rb = item / nkb, kb = item % nkb, k0 = 64 * kb, r0 = 32 * rb;
    const int sc = srccol(r0 + (lane & 31));
#pragma unroll 8
    for (int i = 0; i < 32; ++i) { const int kk = 2 * i + (lane >> 5); scr[kk * 33 + (lane & 31)] = sc >= 0 ? W[(size_t)(k0 + kk) * N + sc] : 0.f; }
    asm volatile("s_waitcnt lgkmcnt(0)" ::: "memory");
    const int c = lane & 7;
#pragma unroll
    for (int j = 0; j < 4; ++j) { const int n = (lane >> 3) + 8 * j; const LAS float* s = scr + (8 * c) * 33 + n;
        u32x4 o; o.x = cvt_pk_bf16(s[0 * 33], s[1 * 33]); o.y = cvt_pk_bf16(s[2 * 33], s[3 * 33]); o.z = cvt_pk_bf16(s[4 * 33], s[5 * 33]); o.w = cvt_pk_bf16(s[6 * 33], s[7 * 33]);
        *(u32x4*)(WT + (size_t)(r0 + n) * K + k0 + 8 * c) = o; }
    asm volatile("s_waitcnt lgkmcnt(0)" ::: "memory");
}
__device__ __forceinline__ int map_gu(int r) { const int pn = r >> 8, bj = (r >> 7) & 1, p = r & 127; return bj * DFF + pn * 128 + p; }
__device__ __forceinline__ int map_id(int r) { return r; }
__device__ __forceinline__ int map_win(int r) {
    if (r < 1536) return r;
    if (r < 2816) {
        const int pn = r >> 8, bj = (r >> 7) & 1, p = r & 127, hl = p >> 5, j = p & 31;
        if (pn == 6 || pn == 7) return SC_Q + (4 * (pn - 6) + hl) * 64 + bj * 32 + j;
        if (pn == 8) return hl < 2 ? SC_K + hl * 64 + bj * 32 + j : SC_V + (hl - 2) * 64 + bj * 32 + j;
        if (pn == 9) return SC_QI + hl * 64 + bj * 32 + j;
        if (hl == 0) return SC_KI + bj * 32 + j;
        if (hl == 1 && bj == 0) { if (j < 4) return SC_WI + j; if (j < 8) return SC_MI + (j - 4); if (j < 12) return SC_MF + (j - 8); }
        return -1;
    }
    if (r < 4864) return SC_MQ + (r - 2816);
    return SC_GT + (r - 4864);
}

__device__ __forceinline__ void norm_row(const bf16_t* yrow, float* hrow, bf16_t* urow, const float* ga, const float* gb, float cscale, int lane) {
    asm volatile("" : "+v"(lane));
    const u32x2* yr = (const u32x2*)yrow + lane; f32x4* hr = (f32x4*)hrow + lane;
    f32x4 yv[4]; float ss = 0.f;
#pragma unroll
    for (int j = 0; j < 4; ++j) { const u32x2 w = yr[64 * j]; yv[j] = (f32x4){bf_lo(w.x), bf_hi(w.x), bf_lo(w.y), bf_hi(w.y)}; ss += (yv[j][0] * yv[j][0] + yv[j][1] * yv[j][1]) + (yv[j][2] * yv[j][2] + yv[j][3] * yv[j][3]); }
    const float rs = 1.0f / sqrtf(wave_sum(ss) * (1.0f / DM) + EPS);
    f32x4 hn[4]; float s2 = 0.f;
#pragma unroll
    for (int j = 0; j < 4; ++j) { const f32x4 g4 = ((const f32x4*)ga)[lane + 64 * j]; hn[j] = hr[64 * j] + cscale * (yv[j] * rs * g4); hr[64 * j] = hn[j];
        s2 += (hn[j][0] * hn[j][0] + hn[j][1] * hn[j][1]) + (hn[j][2] * hn[j][2] + hn[j][3] * hn[j][3]); }
    const float rs2 = 1.0f / sqrtf(wave_sum(s2) * (1.0f / DM) + EPS);
    u32x2* ur = (u32x2*)urow + lane;
#pragma unroll
    for (int j = 0; j < 4; ++j) { const f32x4 g4 = ((const f32x4*)gb)[lane + 64 * j]; const f32x4 o = hn[j] * rs2 * g4; u32x2 w; w.x = cvt_pk_bf16(o[0], o[1]); w.y = cvt_pk_bf16(o[2], o[3]); ur[64 * j] = w; }
}
__device__ __forceinline__ void init_row(const float* src, float* hrow, bf16_t* urow, const float* gb, int lane) {
    asm volatile("" : "+v"(lane));
    const f32x4* sr = (const f32x4*)src + lane; f32x4* hr = (f32x4*)hrow + lane;
    f32x4 hn[4]; float s2 = 0.f;
#pragma unroll
    for (int j = 0; j < 4; ++j) { hn[j] = sr[64 * j]; hr[64 * j] = hn[j]; s2 += (hn[j][0] * hn[j][0] + hn[j][1] * hn[j][1]) + (hn[j][2] * hn[j][2] + hn[j][3] * hn[j][3]); }
    const float rs2 = 1.0f / sqrtf(wave_sum(s2) * (1.0f / DM) + EPS);
    u32x2* ur = (u32x2*)urow + lane;
#pragma unroll
    for (int j = 0; j < 4; ++j) { const f32x4 g4 = ((const f32x4*)gb)[lane + 64 * j]; const f32x4 o = hn[j] * rs2 * g4; u32x2 w; w.x = cvt_pk_bf16(o[0], o[1]); w.y = cvt_pk_bf16(o[2], o[3]); ur[64 * j] = w; }
}

__device__ __forceinline__ float wave_incl_sum(float v, int lane) {
#pragma unroll
    for (int o = 1; o < 64; o <<= 1) { const float t = __shfl_up(v, o); if (lane >= o) v += t; }
    return v;
}
__device__ __forceinline__ float wave_incl_max(float v, int lane) {
#pragma unroll
    for (int o = 1; o < 64; o <<= 1) { const float t = __shfl_up(v, o); if (lane >= o) v = fmaxf(v, t); }
    return v;
}
__device__ __forceinline__ unsigned wave_incl_sum_u(unsigned v, int lane) {
#pragma unroll
    for (int o = 1; o < 64; o <<= 1) { const unsigned t = __shfl_up(v, o); if (lane >= o) v += t; }
    return v;
}
__device__ __forceinline__ float wave_max(float v) {
#pragma unroll
    for (int o = 1; o < 64; o <<= 1) v = fmaxf(v, __shfl_xor(v, o));
    return v;
}
__device__ __forceinline__ unsigned keep_low(unsigned x, unsigned n) { unsigned cnt = __popc(x); while (cnt > n) { x &= ~(0x80000000u >> __clz(x)); --cnt; } return x; }
#define LDSW() asm volatile("s_waitcnt lgkmcnt(0)" ::: "memory")

__device__ __forceinline__ void conv_item(bf16_t* P, const float* wconv  , int ci, int tid) {
    asm volatile("" : "+v"(tid));
    for (int i = tid; i < 128 * 64; i += 512) {
        const int rl = 128 * ci + (i >> 6); if (rl >= MH) break;
        const int ch = (i & 63) * 8; const int t = rl % T;
        bf16_t* row = P + (size_t)rl * LDP;
        const u32x4 cb = *(const u32x4*)(row + PC_CB + ch);
        float u0[8], u1[8], u2[8];
        { const u32x4 x = *(const u32x4*)(row + PC_CX + ch), cz = *(const u32x4*)(row + PC_CC + ch);
#pragma unroll
          for (int j = 0; j < 4; ++j) { u0[2 * j] = bf_lo(x[j]) * bf_lo(cz[j]); u0[2 * j + 1] = bf_hi(x[j]) * bf_hi(cz[j]); } }
        if (t >= 1) { const u32x4 x = *(const u32x4*)(row - LDP + PC_CX + ch), cz = *(const u32x4*)(row - LDP + PC_CC + ch);
#pragma unroll
          for (int j = 0; j < 4; ++j) { u1[2 * j] = bf_lo(x[j]) * bf_lo(cz[j]); u1[2 * j + 1] = bf_hi(x[j]) * bf_hi(cz[j]); } }
        else {
#pragma unroll
          for (int j = 0; j < 8; ++j) u1[j] = 0.f; }
        if (t >= 2) { const u32x4 x = *(const u32x4*)(row - 2 * LDP + PC_CX + ch), cz = *(const u32x4*)(row - 2 * LDP + PC_CC + ch);
#pragma unroll
          for (int j = 0; j < 4; ++j) { u2[2 * j] = bf_lo(x[j]) * bf_lo(cz[j]); u2[2 * j + 1] = bf_hi(x[j]) * bf_hi(cz[j]); } }
        else {
#pragma unroll
          for (int j = 0; j < 8; ++j) u2[j] = 0.f; }
        const f32x4 w0a = *(const f32x4*)(wconv + ch), w0b = *(const f32x4*)(wconv + ch + 4), w1a = *(const f32x4*)(wconv + 512 + ch), w1b = *(const f32x4*)(wconv + 512 + ch + 4),
                    w2a = *(const f32x4*)(wconv + 1024 + ch), w2b = *(const f32x4*)(wconv + 1024 + ch + 4);
        float o[8];
#pragma unroll
        for (int j = 0; j < 8; ++j) { const float w0 = j < 4 ? w0a[j] : w0b[j - 4], w1 = j < 4 ? w1a[j] : w1b[j - 4], w2 = j < 4 ? w2a[j] : w2b[j - 4];
            const float cbv = (j & 1) ? bf_hi(cb[j >> 1]) : bf_lo(cb[j >> 1]);
            o[j] = cbv * (w0 * u2[j] + w1 * u1[j] + w2 * u0[j]); }
        u32x4 w; w.x = cvt_pk_bf16(o[0], o[1]); w.y = cvt_pk_bf16(o[2], o[3]); w.z = cvt_pk_bf16(o[4], o[5]); w.w = cvt_pk_bf16(o[6], o[7]);
        *(u32x4*)(row + PC_CB + ch) = w;
    }
}

constexpr int SA_HIST = 0, SA_GT = 16384, SA_EQ = 24832, SA_SEL = 33280, SA_LIST = 33408, SA_SP = 37504;
__device__ __forceinline__ void selattn_item(LAS unsigned char* lds, bf16_t* P, const bf16_t* KV, const bf16_t* KI, int bl, int qb, int tid, int lane, int wave) {
    asm volatile("" : "+v"(tid)); lane = tid & 63;
    const int t0 = qb * 16, nkt = qb + 1; const size_t rowbase = (size_t)bl * T;
    const int c16 = lane & 15, g4 = lane >> 4;
    LAS unsigned* hist = (LAS unsigned*)(lds + SA_HIST);
    LAS unsigned* selp = (LAS unsigned*)(lds + SA_SEL);
    const bool selall = (qb < 16);
    for (int i = tid; i < 2 * 16 * 132; i += 512) ((LAS unsigned*)(lds + SA_GT))[i] = 0u;
    if (tid < 16) { selp[tid] = 0u; selp[16 + tid] = 256u; }
    bf16x8 aq[4][2];
    { const bf16_t* qrow = P + (rowbase + t0 + c16) * LDP + PC_QI + g4 * 8;
#pragma unroll
      for (int h = 0; h < 4; ++h)
#pragma unroll
          for (int ks = 0; ks < 2; ++ks) aq[h][ks] = *(const bf16x8*)(qrow + h * 64 + ks * 32); }
    float wq[4][4];
#pragma unroll
    for (int r = 0; r < 4; ++r) { const u32x2 w = *(const u32x2*)(P + (rowbase + t0 + 4 * g4 + r) * LDP + PC_WI);
        wq[r][0] = bf_lo(w.x) * 0.0625f; wq[r][1] = bf_hi(w.x) * 0.0625f; wq[r][2] = bf_lo(w.y) * 0.0625f; wq[r][3] = bf_hi(w.y) * 0.0625f; }
    unsigned sc[33][4];
#pragma unroll
    for (int s = 0; s < 33; ++s) {
        const int kt = wave + 8 * s;
        if (kt < nkt) {
            const bf16_t* kr = KI + (rowbase + kt * 16 + c16) * 64 + g4 * 8;
            const bf16x8 b0 = *(const bf16x8*)kr, b1 = *(const bf16x8*)(kr + 32);
            f32x4 ac[4];
#pragma unroll
            for (int h = 0; h < 4; ++h) { ac[h] = __builtin_amdgcn_mfma_f32_16x16x32_bf16(aq[h][0], b0, (f32x4){0.f, 0.f, 0.f, 0.f}, 0, 0, 0); ac[h] = __builtin_amdgcn_mfma_f32_16x16x32_bf16(aq[h][1], b1, ac[h], 0, 0, 0); }
#pragma unroll
            for (int r = 0; r < 4; ++r) {
                float sv = wq[r][0] * fmaxf(ac[0][r], 0.f);
                sv = __builtin_fmaf(wq[r][1], fmaxf(ac[1][r], 0.f), sv); sv = __builtin_fmaf(wq[r][2], fmaxf(ac[2][r], 0.f), sv); sv = __builtin_fmaf(wq[r][3], fmaxf(ac[3][r], 0.f), sv);
                unsigned bits = __float_as_uint(sv); bits = (bits == 0x80000000u) ? 0u : bits;
                const unsigned key = bits ^ ((unsigned)((int)bits >> 31) | 0x80000000u);
                sc[s][r] = (kt * 16 + c16 <= t0 + 4 * g4 + r) ? key : 0u;
            }
        } else { sc[s][0] = 0u; sc[s][1] = 0u; sc[s][2] = 0u; sc[s][3] = 0u; }
    }
    __syncthreads();
    if (!selall) {
#pragma unroll 1
        for (int p = 0; p < 4; ++p) {
            const int shift = 24 - 8 * p; const unsigned hmask = (p == 0) ? 0u : (0xFFFFFFFFu << (shift + 8));
            for (int i = tid; i < 4096; i += 512) hist[i] = 0u;
            __syncthreads();
            unsigned pf[4];
#pragma unroll
            for (int r = 0; r < 4; ++r) pf[r] = selp[4 * g4 + r];
#pragma unroll
            for (int s = 0; s < 33; ++s)
#pragma unroll
                for (int r = 0; r < 4; ++r) { const unsigned key = sc[s][r];
                    if (key != 0u && ((key ^ pf[r]) & hmask) == 0u) __hip_atomic_fetch_add(&hist[(4 * g4 + r) * 256 + ((key >> shift) & 255u)], 1u, __ATOMIC_RELAXED, __HIP_MEMORY_SCOPE_WORKGROUP); }
            __syncthreads();
#pragma unroll
            for (int qq = 0; qq < 2; ++qq) { const int q = 2 * wave + qq;
                const u32x4 cnt = *(const LAS u32x4*)&hist[q * 256 + 252 - 4 * lane];
                const unsigned tot = cnt.x + cnt.y + cnt.z + cnt.w;
                const unsigned inc = wave_incl_sum_u(tot, lane), exc = inc - tot;
                const unsigned krem = selp[16 + q];
                if (exc < krem && krem <= inc) {
                    unsigned cum = exc; int d;
                    if (krem <= cum + cnt.w) d = 255 - 4 * lane; else { cum += cnt.w; if (krem <= cum + cnt.z) d = 254 - 4 * lane; else { cum += cnt.z; if (krem <= cum + cnt.y) d = 253 - 4 * lane; else { cum += cnt.y; d = 252 - 4 * lane; } } }
                    selp[q] = selp[q] | ((unsigned)d << shift); selp[16 + q] = krem - cum;
                }
            }
            __syncthreads();
        }
    }
    {
        int nkt3 = nkt; asm volatile("" : "+s"(nkt3));
        unsigned tau[4];
#pragma unroll
        for (int r = 0; r < 4; ++r) tau[r] = selall ? 0u : selp[4 * g4 + r];
        LAS unsigned long long* bg64 = (LAS unsigned long long*)(lds + SA_GT); LAS unsigned long long* be64 = (LAS unsigned long long*)(lds + SA_EQ);
#pragma unroll
        for (int s = 0; s < 33; ++s) {
            const int kt = wave + 8 * s;
            if (kt < nkt3) {
#pragma unroll
                for (int r = 0; r < 4; ++r) { const unsigned key = sc[s][r]; const bool g = selall ? (key != 0u) : (key > tau[r]); const bool e = (!selall) && (key == tau[r]);
                    const unsigned long long vg = __ballot(g), ve = __ballot(e);
                    if (lane == 0) { bg64[kt * 4 + r] = vg; be64[kt * 4 + r] = ve; } }
            }
            __builtin_amdgcn_sched_barrier(0);
        }
    }
    __syncthreads();
    LAS unsigned short* list = (LAS unsigned short*)(lds + SA_LIST + wave * 512);
    LAS float* sP = (LAS float*)(lds + SA_SP + wave * 8192);
#pragma unroll 1
    for (int qq = 0; qq < 2; ++qq) {
        const int q = 2 * wave + qq, tq = t0 + q;
        const LAS unsigned short* hgt = (const LAS unsigned short*)(lds + SA_GT) + (q & 3) * 4 + (q >> 2); const LAS unsigned short* heq = (const LAS unsigned short*)(lds + SA_EQ) + (q & 3) * 4 + (q >> 2);
#define SA_WORD(hp, j) ((unsigned)(hp)[(2 * (j)) * 16] | ((unsigned)(hp)[(2 * (j) + 1) * 16] << 16))
        unsigned g0 = SA_WORD(hgt, lane), g1 = SA_WORD(hgt, lane + 64), g2 = lane < 4 ? SA_WORD(hgt, lane + 128) : 0u;
        unsigned e0 = SA_WORD(heq, lane), e1 = SA_WORD(heq, lane + 64), e2 = lane < 4 ? SA_WORD(heq, lane + 128) : 0u;
#undef SA_WORD
        const unsigned krem = selall ? 0u : selp[16 + q];
        {
            const unsigned c0 = __popc(e0), c1 = __popc(e1), c2 = __popc(e2);
            const unsigned i0 = wave_incl_sum_u(c0, lane), i1 = wave_incl_sum_u(c1, lane), i2 = wave_incl_sum_u(c2, lane);
            const unsigned T0 = __shfl(i0, 63), T1 = __shfl(i1, 63);
            const unsigned x0 = i0 - c0, x1 = T0 + i1 - c1, x2 = T0 + T1 + i2 - c2;
            e0 = keep_low(e0, krem > x0 ? krem - x0 : 0u); e1 = keep_low(e1, krem > x1 ? krem - x1 : 0u); e2 = keep_low(e2, krem > x2 ? krem - x2 : 0u);
        }
        g0 |= e0; g1 |= e1; g2 |= e2;
        int nsel;
        {
            const unsigned c0 = __popc(g0), c1 = __popc(g1), c2 = __popc(g2);
            const unsigned i0 = wave_incl_sum_u(c0, lane), i1 = wave_incl_sum_u(c1, lane), i2 = wave_incl_sum_u(c2, lane);
            const unsigned T0 = __shfl(i0, 63), T1 = __shfl(i1, 63), T2 = __shfl(i2, 63);
            unsigned o0 = i0 - c0, o1 = T0 + i1 - c1, o2 = T0 + T1 + i2 - c2;
            nsel = (int)(T0 + T1 + T2); nsel = nsel > 256 ? 256 : nsel;
            while (g0) { const int b = __ffs(g0) - 1; if (o0 < 256u) list[o0] = (unsigned short)(32 * lane + b); ++o0; g0 &= g0 - 1u; }
            while (g1) { const int b = __ffs(g1) - 1; if (o1 < 256u) list[o1] = (unsigned short)(32 * (lane + 64) + b); ++o1; g1 &= g1 - 1u; }
            while (g2) { const int b = __ffs(g2) - 1; if (o2 < 256u) list[o2] = (unsigned short)(32 * (lane + 128) + b); ++o2; g2 &= g2 - 1u; }
        }
        LDSW();
        bf16x8 qa[2][2];
#pragma unroll
        for (int g = 0; g < 2; ++g)
#pragma unroll
            for (int ks = 0; ks < 2; ++ks) { bf16x8 v = {0, 0, 0, 0, 0, 0, 0, 0};
                if (c16 < 4) v = *(const bf16x8*)(P + (rowbase + tq) * LDP + PC_Q + (4 * g + c16) * 64 + 8 * g4 + 32 * ks);
                qa[g][ks] = v; }
        const int ngrp = (nsel + 15) >> 4;
#pragma unroll 2
        for (int kg = 0; kg < ngrp; ++kg) {
            const int kk = 16 * kg + c16; const int idx = kk < nsel ? (int)list[kk] : 0;
            const bf16_t* kvrow = KV + (rowbase + idx) * 256 + 8 * g4;
#pragma unroll
            for (int g = 0; g < 2; ++g) {
                const bf16x8 b0 = *(const bf16x8*)(kvrow + g * 64), b1 = *(const bf16x8*)(kvrow + g * 64 + 32);
                f32x4 ac = __builtin_amdgcn_mfma_f32_16x16x32_bf16(qa[g][0], b0, (f32x4){0.f, 0.f, 0.f, 0.f}, 0, 0, 0);
                ac = __builtin_amdgcn_mfma_f32_16x16x32_bf16(qa[g][1], b1, ac, 0, 0, 0);
                if (g4 == 0) { const float ninf = -__builtin_inff(); f32x4 o = ac * 0.125f; if (kk >= nsel) o = (f32x4){ninf, ninf, ninf, ninf}; *(LAS f32x4*)&sP[kk * 8 + 4 * g] = o; }
            }
        }
        LDSW();
        float inv[8];
        {
            f32x4 sa_[4][2]; float mx[8];
#pragma unroll
            for (int h = 0; h < 8; ++h) mx[h] = -__builtin_inff();
#pragma unroll
            for (int i = 0; i < 4; ++i) { const int kk = lane + 64 * i;
                if (kk < nsel) { sa_[i][0] = *(const LAS f32x4*)&sP[kk * 8]; sa_[i][1] = *(const LAS f32x4*)&sP[kk * 8 + 4]; }
                else { const float ninf = -__builtin_inff(); sa_[i][0] = (f32x4){ninf, ninf, ninf, ninf}; sa_[i][1] = sa_[i][0]; }
#pragma unroll
                for (int h = 0; h < 8; ++h) mx[h] = fmaxf(mx[h], sa_[i][h >> 2][h & 3]); }
            float sm[8];
#pragma unroll
            for (int h = 0; h < 8; ++h) { mx[h] = wave_max(mx[h]); sm[h] = 0.f; }
#pragma unroll
            for (int i = 0; i < 4; ++i) { const int kk = lane + 64 * i;
#pragma unroll
                for (int h = 0; h < 8; ++h) { const float pv = (kk < nsel) ? fast_exp(sa_[i][h >> 2][h & 3] - mx[h]) : 0.f; sa_[i][h >> 2][h & 3] = pv; sm[h] += pv; }
                if (kk < nsel) { *(LAS f32x4*)&sP[kk * 8] = sa_[i][0]; *(LAS f32x4*)&sP[kk * 8 + 4] = sa_[i][1]; } }
#pragma unroll
            for (int h = 0; h < 8; ++h) inv[h] = 1.0f / wave_sum(sm[h]);
        }
        LDSW();
        float oacc[4][2];
#pragma unroll
        for (int hh = 0; hh < 4; ++hh) { oacc[hh][0] = 0.f; oacc[hh][1] = 0.f; }
        const int gsel = lane >> 5;
        const unsigned* kvd = (const unsigned*)KV + rowbase * 128 + 64 + lane;
#pragma unroll 4
        for (int k = 0; k < nsel; ++k) {
            const int idx = (int)list[k];
            const unsigned v = kvd[(size_t)idx * 128];
            const f32x4 p4 = *(const LAS f32x4*)&sP[k * 8 + 4 * gsel];
            const float vlo = bf_lo(v), vhi = bf_hi(v);
#pragma unroll
            for (int hh = 0; hh < 4; ++hh) { oacc[hh][0] = __builtin_fmaf(p4[hh], vlo, oacc[hh][0]); oacc[hh][1] = __builtin_fmaf(p4[hh], vhi, oacc[hh][1]); }
        }
        unsigned* orow = (unsigned*)(P + (rowbase + tq) * LDP + PC_Q) + (lane & 31);
#pragma unroll
        for (int hh = 0; hh < 4; ++hh) { const float iv = gsel ? inv[4 + hh] : inv[hh]; orow[(4 * gsel + hh) * 32] = cvt_pk_bf16(oacc[hh][0] * iv, oacc[hh][1] * iv); }
        LDSW();
    }
}

constexpr int ML_Q = 0, ML_K = 17408, ML_KT = 34816, ML_VT = 53248, ML_SCR = 71680, ML_SS = 83968, ML_N = 86016, ML_QN = 86528;
constexpr int QS = 272, TS = 144;
__device__ __forceinline__ bf16x8 mk_frag(u32x2 lo, u32x2 hi) { u32x4 w; w.x = lo.x; w.y = lo.y; w.z = hi.x; w.w = hi.y; return __builtin_bit_cast(bf16x8, w); }
__device__ __forceinline__ void mlstm_item(LAS unsigned char* lds, bf16_t* P, const float* b_i, const float* b_f, const float* mh_g, int bl, int hd, int tid, int lane, int wave) {
    asm volatile("" : "+v"(tid)); lane = tid & 63;
    const size_t rowbase = (size_t)bl * T;
    const int c16 = lane & 15, g4 = lane >> 4;
    LAS float* scr = (LAS float*)(lds + ML_SCR + wave * 1536);
    LAS float* sA = scr, *sM = scr + 64, *sI = scr + 128, *sE = scr + 192, *sW = scr + 256, *sR = scr + 320;
    LAS float* sss = (LAS float*)(lds + ML_SS); LAS float* sn = (LAS float*)(lds + ML_N); LAS float* sqn = (LAS float*)(lds + ML_QN);
    const float bi = b_i[hd], bfg = b_f[hd];
    const float gmh = mh_g[hd * 128 + 16 * wave + c16];
    if (tid < 128) sn[tid] = 0.f;
    f32x4 cst[8];
#pragma unroll
    for (int dt = 0; dt < 8; ++dt) cst[dt] = (f32x4){0.f, 0.f, 0.f, 0.f};
    float mrun = 0.f;
    const int sl = tid >> 4, scc = tid & 15;
    u32x4 pq[2], pk[2], pv[2]; unsigned pgate = 0u;
    const bf16_t* colq = P + PC_MQ + hd * 128 + 8 * scc;
#define ML_PREFETCH(cn) do { \
        _Pragma("unroll") for (int k2 = 0; k2 < 2; ++k2) { const int tt = 64 * (cn) - 48 + sl + 32 * k2; \
            if (tt >= 0) { const bf16_t* rp = colq + (rowbase + tt) * LDP; pq[k2] = *(const u32x4*)rp; pk[k2] = *(const u32x4*)(rp + 512); pv[k2] = *(const u32x4*)(rp + 1024); } \
            else { pq[k2] = (u32x4){0u, 0u, 0u, 0u}; pk[k2] = pq[k2]; pv[k2] = pq[k2]; } } \
        { const int tt = 64 * (cn) - 48 + lane; pgate = 0u; if (tt >= 0) { const bf16_t* gp = P + (rowbase + tt) * LDP; pgate = (unsigned)gp[PC_MI + hd] | ((unsigned)gp[PC_MF + hd] << 16); } } \
    } while (0)
    ML_PREFETCH(0);
    __syncthreads();
#pragma unroll 1
    for (int c = 0; c < 65; ++c) {
        float decay, mnew;
        {
            const int tt = 64 * c - 48 + lane;
            float logi = -__builtin_inff(), lf = 0.f;
            if (tt >= 0) { logi = bf_lo(pgate) + bi; const float f = bf_hi(pgate) + bfg; lf = fminf(f, 0.f) - log1pf(expf(-fabsf(f))); }
            const float b = wave_incl_sum(lf, lane);
            const float av = logi - b;
            const float Am = wave_incl_max(av, lane);
            const float Mx = fmaxf(mrun, Am);
            const float bL = __shfl(b, 63), M63 = __shfl(Mx, 63);
            sA[lane] = av; sM[lane] = Mx; sI[lane] = fast_exp(mrun - Mx); sE[lane] = fast_exp(-(b + Mx)); sW[lane] = fast_exp(av - M63) * 0.08838834764831845f;
            decay = fast_exp(mrun - M63); mnew = bL + M63;
        }
        LDSW();
#pragma unroll
        for (int k2 = 0; k2 < 2; ++k2) { const int l = sl + 32 * k2;
            *(LAS u32x4*)(lds + ML_Q + l * QS + scc * 16) = pq[k2]; *(LAS u32x4*)(lds + ML_K + l * QS + scc * 16) = pk[k2];
            const float wk = sW[l];
#pragma unroll
            for (int j = 0; j < 4; ++j) { const unsigned kw = pk[k2][j], vw = pv[k2][j];
                const unsigned ks = cvt_pk_bf16(bf_lo(kw) * wk, bf_hi(kw) * wk);
                *(LAS unsigned short*)(lds + ML_KT + (8 * scc + 2 * j) * TS + l * 2) = (unsigned short)ks; *(LAS unsigned short*)(lds + ML_KT + (8 * scc + 2 * j + 1) * TS + l * 2) = (unsigned short)(ks >> 16);
                *(LAS unsigned short*)(lds + ML_VT + (8 * scc + 2 * j) * TS + l * 2) = (unsigned short)vw; *(LAS unsigned short*)(lds + ML_VT + (8 * scc + 2 * j + 1) * TS + l * 2) = (unsigned short)(vw >> 16); } }
        LDSW();
        __syncthreads();
        unsigned mo2[4][2];
#pragma unroll
        for (int lt = 0; lt < 4; ++lt)
#pragma unroll
            for (int rp = 0; rp < 2; ++rp) { const int tt = 64 * c - 48 + 16 * lt + 4 * g4 + 2 * rp; unsigned w = 0u;
                if (tt >= 0) { const bf16_t* mp = P + (rowbase + tt) * LDP + PC_MO + hd * 128 + 16 * wave + c16; w = (unsigned)mp[0] | ((unsigned)mp[LDP] << 16); }
                mo2[lt][rp] = w; }
        {
            const int tok = 8 * wave + (lane >> 3), dch = lane & 7;
            const u32x4 q0 = *(const LAS u32x4*)(lds + ML_Q + tok * QS + dch * 32), q1 = *(const LAS u32x4*)(lds + ML_Q + tok * QS + dch * 32 + 16);
            float acc = 0.f;
#pragma unroll
            for (int j = 0; j < 4; ++j) { const f32x4 n4 = *(const LAS f32x4*)&sn[16 * dch + 4 * j]; const unsigned wa = j < 2 ? q0[2 * j] : q1[2 * j - 4], wb = j < 2 ? q0[2 * j + 1] : q1[2 * j - 3];
                acc += bf_lo(wa) * n4[0] + bf_hi(wa) * n4[1] + bf_lo(wb) * n4[2] + bf_hi(wb) * n4[3]; }
            acc += __shfl_xor(acc, 1); acc += __shfl_xor(acc, 2); acc += __shfl_xor(acc, 4);
            if (dch == 0) sqn[tok] = acc;
        }
        bf16x8 wfrag[4][2];
        {
            f32x4 a4[4];
#pragma unroll
            for (int st = 0; st < 4; ++st) a4[st] = *(const LAS f32x4*)&sA[16 * st + 4 * g4];
#pragma unroll
            for (int lt = 0; lt < 4; ++lt) {
                bf16x8 qf[4];
#pragma unroll
                for (int kd = 0; kd < 4; ++kd) qf[kd] = *(const LAS bf16x8*)(lds + ML_Q + (16 * lt + c16) * QS + (32 * kd + 8 * g4) * 2);
                const float Ml = sM[16 * lt + c16];
                float val[4][4]; float rsum = 0.f;
#pragma unroll
                for (int st = 0; st < 4; ++st) {
                    if (st <= lt) {
                        f32x4 ac = (f32x4){0.f, 0.f, 0.f, 0.f};
#pragma unroll
                        for (int kd = 0; kd < 4; ++kd) { const bf16x8 kf = *(const LAS bf16x8*)(lds + ML_K + (16 * st + c16) * QS + (32 * kd + 8 * g4) * 2); ac = __builtin_amdgcn_mfma_f32_16x16x32_bf16(kf, qf[kd], ac, 0, 0, 0); }
#pragma unroll
                        for (int r = 0; r < 4; ++r) { const int s = 16 * st + 4 * g4 + r, l = 16 * lt + c16; val[st][r] = (s <= l) ? fast_exp(a4[st][r] - Ml) * ac[r] * 0.08838834764831845f : 0.f; rsum += val[st][r]; }
                    } else {
#pragma unroll
                        for (int r = 0; r < 4; ++r) val[st][r] = 0.f;
                    }
                }
                rsum += __shfl_xor(rsum, 16); rsum += __shfl_xor(rsum, 32);
                if (g4 == 0) sR[16 * lt + c16] = rsum;
#pragma unroll
                for (int ks2 = 0; ks2 < 2; ++ks2) { u32x4 w; w.x = cvt_pk_bf16(val[2 * ks2][0], val[2 * ks2][1]); w.y = cvt_pk_bf16(val[2 * ks2][2], val[2 * ks2][3]);
                    w.z = cvt_pk_bf16(val[2 * ks2 + 1][0], val[2 * ks2 + 1][1]); w.w = cvt_pk_bf16(val[2 * ks2 + 1][2], val[2 * ks2 + 1][3]); wfrag[lt][ks2] = __builtin_bit_cast(bf16x8, w); }
            }
        }
        f32x4 num[4];
        {
            bf16x8 cf[4];
#pragma unroll
            for (int kd = 0; kd < 4; ++kd) { u32x4 w; w.x = cvt_pk_bf16(cst[2 * kd][0], cst[2 * kd][1]); w.y = cvt_pk_bf16(cst[2 * kd][2], cst[2 * kd][3]);
                w.z = cvt_pk_bf16(cst[2 * kd + 1][0], cst[2 * kd + 1][1]); w.w = cvt_pk_bf16(cst[2 * kd + 1][2], cst[2 * kd + 1][3]); cf[kd] = __builtin_bit_cast(bf16x8, w); }
#pragma unroll
            for (int lt = 0; lt < 4; ++lt) {
                f32x4 ah = (f32x4){0.f, 0.f, 0.f, 0.f}, aqc = (f32x4){0.f, 0.f, 0.f, 0.f};
#pragma unroll
                for (int ks2 = 0; ks2 < 2; ++ks2) { const LAS unsigned char* vp = lds + ML_VT + (16 * wave + c16) * TS + (32 * ks2 + 4 * g4) * 2;
                    ah = __builtin_amdgcn_mfma_f32_16x16x32_bf16(wfrag[lt][ks2], mk_frag(*(const LAS u32x2*)vp, *(const LAS u32x2*)(vp + 32)), ah, 0, 0, 0); }
#pragma unroll
                for (int kd = 0; kd < 4; ++kd) { const LAS unsigned char* qp = lds + ML_Q + (16 * lt + c16) * QS + (32 * kd + 4 * g4) * 2;
                    aqc = __builtin_amdgcn_mfma_f32_16x16x32_bf16(mk_frag(*(const LAS u32x2*)qp, *(const LAS u32x2*)(qp + 32)), cf[kd], aqc, 0, 0, 0); }
                const f32x4 in4 = *(const LAS f32x4*)&sI[16 * lt + 4 * g4];
                num[lt] = in4 * aqc + ah;
            }
        }
        if (c + 1 < 65) ML_PREFETCH(c + 1);
        LDSW();
        __syncthreads();
#pragma unroll
        for (int lt = 0; lt < 4; ++lt) {
            const f32x4 qn4 = *(const LAS f32x4*)&sqn[16 * lt + 4 * g4], e4 = *(const LAS f32x4*)&sE[16 * lt + 4 * g4], in4 = *(const LAS f32x4*)&sI[16 * lt + 4 * g4], r4 = *(const LAS f32x4*)&sR[16 * lt + 4 * g4];
            f32x4 sq;
#pragma unroll
            for (int r = 0; r < 4; ++r) { const float den = in4[r] * qn4[r] + r4[r]; const float hv = num[lt][r] / fmaxf(fabsf(den), e4[r]); num[lt][r] = hv; sq[r] = hv * hv; }
#pragma unroll
            for (int o = 1; o < 16; o <<= 1) { sq[0] += __shfl_xor(sq[0], o); sq[1] += __shfl_xor(sq[1], o); sq[2] += __shfl_xor(sq[2], o); sq[3] += __shfl_xor(sq[3], o); }
            if (c16 == 0) *(LAS f32x4*)&sss[wave * 64 + 16 * lt + 4 * g4] = sq;
        }
        LDSW();
        __syncthreads();
#pragma unroll
        for (int lt = 0; lt < 4; ++lt) {
            f32x4 ss = (f32x4){0.f, 0.f, 0.f, 0.f};
#pragma unroll
            for (int w8 = 0; w8 < 8; ++w8) ss += *(const LAS f32x4*)&sss[w8 * 64 + 16 * lt + 4 * g4];
#pragma unroll
            for (int r = 0; r < 4; ++r) { const int tt = 64 * c - 48 + 16 * lt + 4 * g4 + r;
                if (tt >= 0) { const float rs = 1.0f / sqrtf(ss[r] * (1.0f / 128.0f) + EPS); const unsigned mw = mo2[lt][r >> 1]; const float mo = (r & 1) ? bf_hi(mw) : bf_lo(mw);
                    const float yv = num[lt][r] * rs * gmh * sigmoidf_(mo);
                    P[(rowbase + tt) * LDP + PC_MO + hd * 128 + 16 * wave + c16] = (bf16_t)(cvt_pk_bf16(yv, 0.f) & 0xffffu); } }
        }
        {
            bf16x8 vf[2];
#pragma unroll
            for (int ks = 0; ks < 2; ++ks) vf[ks] = *(const LAS bf16x8*)(lds + ML_VT + (16 * wave + c16) * TS + (32 * ks + 8 * g4) * 2);
#pragma unroll
            for (int dt = 0; dt < 8; ++dt) { f32x4 cc = cst[dt] * decay;
#pragma unroll
                for (int ks = 0; ks < 2; ++ks) { const bf16x8 kf = *(const LAS bf16x8*)(lds + ML_KT + (16 * dt + c16) * TS + (32 * ks + 8 * g4) * 2); cc = __builtin_amdgcn_mfma_f32_16x16x32_bf16(kf, vf[ks], cc, 0, 0, 0); }
                cst[dt] = cc; }
            if (tid < 128) { float sum = 0.f;
#pragma unroll
                for (int j = 0; j < 8; ++j) { const u32x4 w = *(const LAS u32x4*)(lds + ML_KT + tid * TS + j * 16); sum += (bf_lo(w.x) + bf_hi(w.x)) + (bf_lo(w.y) + bf_hi(w.y)) + (bf_lo(w.z) + bf_hi(w.z)) + (bf_lo(w.w) + bf_hi(w.w)); }
                sn[tid] = decay * sn[tid] + sum; }
        }
        mrun = mnew;
        LDSW();
        __syncthreads();
    }
#undef ML_PREFETCH
}


struct Args { const float* in[12]; float* out; unsigned char* ws; };

__device__ __forceinline__ void convert_layer(const Args& a, int l, bf16_t* wgu0, bf16_t* wgu1, bf16_t* wdn0, bf16_t* wdn1, bf16_t* win, bf16_t* wbr, bf16_t* wout, LAS float* scr, int gw, int NGW, int lane) {
    constexpr int N_GU = (NGU / 32) * (DM / 64), N_DN = (DM / 32) * (DFF / 64), N_IN = (LDP / 32) * (DM / 64), N_BR1 = (DM / 32) * (512 / 64), N_OUT = (DM / 32) * (DM / 64);
    constexpr int NITEMS = 2 * N_GU + 2 * N_DN + N_IN + 3 * N_BR1 + N_OUT;
    const float* sgu = a.in[3] + (size_t)l * 2 * DM * NGU; const float* sdn = a.in[4] + (size_t)l * 2 * DFF * DM;
    const float* sin_ = a.in[5] + (size_t)l * DM * INW; const float* sbr = a.in[10] + (size_t)l * 3 * 512 * DM; const float* sout = a.in[11] + (size_t)l * DM * DM;
    for (int it = gw; it < NITEMS; it += NGW) {
        int r = it;
        if (r < N_GU) { cvt_item(sgu, DM, NGU, wgu0, scr, r, lane, map_gu); continue; } r -= N_GU;
        if (r < N_GU) { cvt_item(sgu + (size_t)DM * NGU, DM, NGU, wgu1, scr, r, lane, map_gu); continue; } r -= N_GU;
        if (r < N_DN) { cvt_item(sdn, DFF, DM, wdn0, scr, r, lane, map_id); continue; } r -= N_DN;
        if (r < N_DN) { cvt_item(sdn + (size_t)DFF * DM, DFF, DM, wdn1, scr, r, lane, map_id); continue; } r -= N_DN;
        if (r < N_IN) { cvt_item(sin_, DM, INW, win, scr, r, lane, map_win); continue; } r -= N_IN;
        if (r < 3 * N_BR1) { const int br = r / N_BR1; cvt_item(sbr + (size_t)br * 512 * DM, 512, DM, wbr + (size_t)br * DM * 512, scr, r - br * N_BR1, lane, map_id); continue; } r -= 3 * N_BR1;
        cvt_item(sout, DM, DM, wout, scr, r, lane, map_id);
    }
}

template <class Tp> __device__ __forceinline__ Tp* opq(Tp* p) { asm volatile("" : "+s"(p)); return p; }
#define GRID_BAR() do { XcdBarrier b_ = bar; asm volatile("" : "+s"(b_.x)); xcd_barrier(b_); } while (0)

__global__ void __launch_bounds__(512, 2) fwd_kernel(Args a) {
    extern __shared__ __attribute__((aligned(16))) unsigned char lds_raw[];
    LAS unsigned char* lds = (LAS unsigned char*)lds_raw;
    const int tid = threadIdx.x, lane = tid & 63, wave = __builtin_amdgcn_readfirstlane(tid >> 6);
    const int G = gridDim.x, c = blockIdx.x;
    const int gw = c * 8 + wave, NGW = G * 8;
    volatile LAS unsigned* MISC = (volatile LAS unsigned*)(lds + LDSCTL_OFF);
    if (tid < 64) MISC[tid] = 0u;
    __syncthreads();
    XcdBarrier bar = xcd_barrier_post((unsigned*)(a.ws + WS_CTL) + CW_BAR, MISC);
#define WSP(T_, off) ((T_*)(w_ + (off)))

    { unsigned char* w_ = opq(a.ws);
      float* ctab = WSP(float, WS_COS); float* stab = WSP(float, WS_SIN);
      for (int i = c * 512 + tid; i < T * 32; i += G * 512) { const int t = i >> 5, j = i & 31;
          const float inv = 1.0f / powf(10000.0f, (float)(2 * j) / 64.0f); const float ang = (float)t * inv; ctab[i] = cosf(ang); stab[i] = sinf(ang); }
      convert_layer(a, 0, WSP(bf16_t, WS_WGU0), WSP(bf16_t, WS_WGU1), WSP(bf16_t, WS_WDN0), WSP(bf16_t, WS_WDN1), WSP(bf16_t, WS_WIN), WSP(bf16_t, WS_WBR), WSP(bf16_t, WS_WOUT), (LAS float*)(lds + wave * 16384), gw, NGW, lane);
      float* H = WSP(float, WS_H); bf16_t* U = (bf16_t*)opq(a.out); const float* g0 = opq(a.in[2]);
      for (int r = gw; r < M; r += NGW) { const int b = r / T, t = r - b * T;
          const float* src = t < NMETA ? a.in[1] + (size_t)t * DM : a.in[0] + ((size_t)b * SEQ + (t - NMETA)) * DM;
          init_row(src, H + (size_t)r * DM, U + (size_t)r * DM, g0, lane); } }
    GRID_BAR();

    int stage = 0;
#pragma unroll 1
    for (int l = 0; l < DEPTH; ++l) {
#pragma unroll 1
        for (int f = 0; f < 2; ++f) {
            if (stage >= DBG_STOP) break;
            { unsigned char* w_ = opq(a.ws); pg8::Gemm gm{(const char*)opq(a.out), nullptr, nullptr, (const char*)(w_ + (f ? WS_WGU1 : WS_WGU0)), 0, DM, DM, DM}; pg8::Sched S; S.init(M / 256, NGU / 256, 1, G, c);
              pg8::EpiSwiglu E{WSP(bf16_t, WS_BIG), DFF}; pg8::gemm_phase(lds, gm, S, E); }
            GRID_BAR();
            { unsigned char* w_ = opq(a.ws); pg8::Gemm gm{(const char*)(w_ + WS_BIG), nullptr, nullptr, (const char*)(w_ + (f ? WS_WDN1 : WS_WDN0)), 0, DFF, DFF, DFF}; pg8::Sched S; S.init(M / 256, DM / 256, 1, G, c);
              pg8::EpiBf16 E{WSP(bf16_t, WS_Y), DM}; pg8::gemm_phase(lds, gm, S, E); }
            GRID_BAR();
            { unsigned char* w_ = opq(a.ws); const bf16_t* Y = WSP(bf16_t, WS_Y); float* H = WSP(float, WS_H); bf16_t* U = (bf16_t*)opq(a.out);
              const float* g = opq(a.in[2]) + (size_t)l * 6 * DM; const float* ga = g + (f ? 5 : 1) * DM;
              const float* gb = f ? opq(a.in[2]) + (size_t)(l + 1 < DEPTH ? l + 1 : l) * 6 * DM : g + 2 * DM;
              for (int r = gw; r < M; r += NGW) norm_row(Y + (size_t)r * DM, H + (size_t)r * DM, U + (size_t)r * DM, ga, gb, 0.5f, lane);
              if (f == 1 && l + 1 < DEPTH) convert_layer(a, l + 1, WSP(bf16_t, WS_WGU0), WSP(bf16_t, WS_WGU1), WSP(bf16_t, WS_WDN0), WSP(bf16_t, WS_WDN1), WSP(bf16_t, WS_WIN), WSP(bf16_t, WS_WBR), WSP(bf16_t, WS_WOUT), (LAS float*)(lds + wave * 16384), gw, NGW, lane); }
            GRID_BAR();
            ++stage;
            if (f == 1) break;
            if (stage >= DBG_STOP) break;
#pragma unroll 1
            for (int hb = 0; hb < 2; ++hb) {
                { unsigned char* w_ = opq(a.ws); pg8::Gemm gm{(const char*)((bf16_t*)opq(a.out) + (size_t)hb * MH * DM), nullptr, nullptr, (const char*)(w_ + WS_WIN), 0, DM, DM, DM}; pg8::Sched S; S.init(MHP / 256, LDP / 256, 1, G, c);
                  pg8::EpiWin E{WSP(bf16_t, WS_BIG), WSP(bf16_t, WS_KV), WSP(bf16_t, WS_KI), WSP(float, WS_COS), WSP(float, WS_SIN)}; pg8::gemm_phase(lds, gm, S, E); }
                GRID_BAR();
                { unsigned char* w_ = opq(a.ws); unsigned* qhead = WSP(unsigned, WS_CTL) + CW_QUEUE + 64 * (l * 2 + hb);
                  bf16_t* P = WSP(bf16_t, WS_BIG);
                  constexpr int N_ML = HBAT * 4, N_SA = HBAT * 257, N_CV = 257;
                  for (;;) {
                      __syncthreads();
                      if (tid == 0) MISC[4] = atomicAdd(qhead, 1u);
                      __syncthreads();
                      const int item = (int)MISC[4];
                      if (item >= N_ML + N_SA + N_CV) break;
                      if (item < N_ML) mlstm_item(lds, P, opq(a.in[7]) + l * 4, opq(a.in[8]) + l * 4, opq(a.in[9]) + (size_t)l * 512, item >> 2, item & 3, tid, lane, wave);
                      else if (item < N_ML + N_SA) { const int qi_ = item - N_ML; selattn_item(lds, P, WSP(bf16_t, WS_KV), WSP(bf16_t, WS_KI), qi_ % HBAT, 256 - qi_ / HBAT, tid, lane, wave); }
                      else conv_item(P, opq(a.in[6]) + (size_t)l * 3 * 512, item - N_ML - N_SA, tid);
                  } }
                GRID_BAR();
                { unsigned char* w_ = opq(a.ws); bf16_t* P = WSP(bf16_t, WS_BIG);
                  pg8::Gemm gm{(const char*)(P + PC_CB), (const char*)(P + PC_Q), (const char*)(P + PC_MO), (const char*)(w_ + WS_WBR), (size_t)DM * 512 * 2, LDP, 512, 512}; pg8::Sched S; S.init(MHP / 256, DM / 256, 3, G, c);
                  pg8::EpiMerge E{P, WSP(bf16_t, WS_Y) + (size_t)hb * MH * DM}; pg8::gemm_phase(lds, gm, S, E); }
                GRID_BAR();
            }
            { unsigned char* w_ = opq(a.ws); pg8::Gemm gm{(const char*)(w_ + WS_Y), nullptr, nullptr, (const char*)(w_ + WS_WOUT), 0, DM, DM, DM}; pg8::Sched S; S.init(M / 256, DM / 256, 1, G, c);
              pg8::EpiBf16 E{(bf16_t*)opq(a.out), DM}; pg8::gemm_phase(lds, gm, S, E); }
            GRID_BAR();
            { unsigned char* w_ = opq(a.ws); float* H = WSP(float, WS_H); bf16_t* U = (bf16_t*)opq(a.out); const float* g = opq(a.in[2]) + (size_t)l * 6 * DM;
              for (int r = gw; r < M; r += NGW) norm_row(U + (size_t)r * DM, H + (size_t)r * DM, U + (size_t)r * DM, g + 3 * DM, g + 4 * DM, 1.0f, lane); }
            GRID_BAR();
            ++stage;
        }
        if (stage >= DBG_STOP) break;
    }
    { unsigned char* w_ = opq(a.ws); const float* H = WSP(float, WS_H); float* out = opq(a.out);
      int ln = lane; asm volatile("" : "+v"(ln));
      for (int r = gw; r < BATCH * SEQ; r += NGW) { const int b = r / SEQ, s = r - b * SEQ;
          const f32x4* hr = (const f32x4*)(H + ((size_t)b * T + NMETA + s) * DM) + ln; f32x4* o = (f32x4*)(out + (size_t)r * DM) + ln;
#pragma unroll
          for (int j = 0; j < 4; ++j) o[64 * j] = hr[64 * j]; } }
#undef WSP
}

extern "C" void kernel_launch(void* const* d_in, const int* in_sizes, int n_in, void* d_out, int out_size, void* d_ws, size_t ws_size, hipStream_t stream) {
    static int grid = 0;
    if (grid == 0) {
        if (n_in != 12 || out_size != BATCH * SEQ * DM || ws_size < WS_END) { fprintf(stderr, "kernel_launch: unexpected shapes (n_in %d, out %d, ws %zu)\n", n_in, out_size, ws_size); grid = -1; return; }
        int dev = 0, cus = 0, per_cu = 0;
        if (hipGetDevice(&dev) != hipSuccess || hipDeviceGetAttribute(&cus, hipDeviceAttributeMultiprocessorCount, dev) != hipSuccess) { grid = -1; return; }
        if (hipFuncSetAttribute((const void*)fwd_kernel, hipFuncAttributeMaxDynamicSharedMemorySize, LDS_BYTES) != hipSuccess) { fprintf(stderr, "kernel_launch: hipFuncSetAttribute failed\n"); grid = -1; return; }
        if (hipOccupancyMaxActiveBlocksPerMultiprocessor(&per_cu, (const void*)fwd_kernel, 512, LDS_BYTES) != hipSuccess || per_cu < 1) { fprintf(stderr, "kernel_launch: occupancy query says %d\n", per_cu); }
        (void)hipGetLastError();
        grid = cus;
    }
    if (grid < 0) return;
    (void)hipMemsetAsync((char*)d_ws + WS_CTL, 0, CTL_ZERO_BYTES, stream);
    Args a{};
    for (int i = 0; i < 12; ++i) a.in[i] = (const float*)d_in[i];
    a.out = (float*)d_out; a.ws = (unsigned char*)d_ws;
    hipLaunchKernelGGL(fwd_kernel, dim3(grid), dim3(512), LDS_BYTES, stream, a);
}
```

```cpp
#include <hip/hip_runtime.h>
#include <cstdio>
#include <cstdint>

#define LAS __attribute__((address_space(3)))
typedef unsigned short bf16_t;
typedef short bf16x8 __attribute__((ext_vector_type(8)));
typedef short bf16x4 __attribute__((ext_vector_type(4)));
typedef float f32x4 __attribute__((ext_vector_type(4)));
typedef float f32x2 __attribute__((ext_vector_type(2)));
typedef unsigned u32x4 __attribute__((ext_vector_type(4)));
typedef unsigned u32x2 __attribute__((ext_vector_type(2)));
typedef short s16x4 __attribute__((ext_vector_type(4)));
typedef int i32x4 __attribute__((ext_vector_type(4)));
typedef _Float16 hres_t;
typedef _Float16 h16x4 __attribute__((ext_vector_type(4)));

#ifndef PROBE_ID
#define PROBE_ID 0
#endif
#define FORCE_FALLBACK 0
#ifndef WIN_INT8
#define WIN_INT8 1
#endif
#define BAR_TWICE 0
#ifndef DBG_STOP
#define DBG_STOP 1000
#endif

constexpr int BATCH = 16, SEQ = 4096, DM = 1024, DEPTH = 4, NMETA = 16;
constexpr int T = SEQ + NMETA;
constexpr int M = BATCH * T;
constexpr int DFF = 2816, NGU = 2 * DFF;
constexpr int INW = 7756, NWIN = 7936, LDP = 4864;
constexpr int HBAT = 8;
constexpr int MH = HBAT * T;
constexpr int MHP = 129 * 256;
constexpr float EPS = 1e-6f;
constexpr int PC_CX = 0, PC_CB = 512, PC_CC = 1024, PC_Q = 1536, PC_QI = 2304, PC_WI = 2624, PC_MI = 2628, PC_MF = 2632;
constexpr int PC_MQ = 2816, PC_MK = 3328, PC_MV = 3840, PC_MO = 4352;
constexpr int SC_Q = 1536, SC_K = 2048, SC_V = 2176, SC_QI = 2304, SC_KI = 2560, SC_WI = 2624, SC_MQ = 2628, SC_MI = 4676, SC_MF = 4680, SC_GT = 4684;

constexpr size_t MiB = 1u << 20;
constexpr size_t WS_CTL = 0, CTL_ZERO_BYTES = 1 * MiB;
constexpr size_t WS_COS = 1 * MiB, WS_SIN = 2 * MiB;
constexpr size_t WS_SW = 5 * MiB;
constexpr size_t WS_SU = 6 * MiB;
constexpr size_t WS_U8B = 812 * MiB;
constexpr size_t WS_YT = 980 * MiB;
constexpr int MT = 256 * 256;
constexpr size_t WS_WGU0 = 8 * MiB, WS_WGU1 = 19 * MiB, WS_WDN0 = 30 * MiB, WS_WDN1 = 36 * MiB, WS_WIN = 42 * MiB, WS_WBR = 58 * MiB, WS_WOUT = 61 * MiB;
constexpr size_t WS_WIN8 = 64 * MiB;
constexpr size_t WS_H = 72 * MiB;
constexpr size_t WS_Y = 329 * MiB;
constexpr size_t WS_BIG = 458 * MiB;
constexpr size_t WS_KV = 958 * MiB;
constexpr size_t WS_KI = 975 * MiB;
constexpr size_t WS_END = 991 * MiB;
constexpr size_t WS_GT = WS_BIG + (size_t)MHP * LDP * 2;
static_assert(WS_GT % 256 == 0 && WS_GT + (size_t)(MHP / 256) * 12 * 131072 <= WS_KV && WS_KV + (size_t)MHP * 512 <= WS_KI && WS_KI + (size_t)MHP * 128 <= WS_YT && WS_YT + (size_t)11 * 256 * DM * 4 <= WS_END, "ws map");
static_assert(WS_H + (size_t)M * DM * 4 <= WS_Y && WS_Y + (size_t)(M + 128) * DM * 2 <= WS_BIG && WS_BIG + (size_t)M * DFF * 2 <= WS_KV, "ws map 2");
constexpr size_t OB_CB = 64 * MiB + 512 * 1024  , OB_NB = 130 * MiB  , OB_SC = 131 * MiB + 512 * 1024  , OB_MB = 131 * MiB + 768 * 1024  ;
constexpr size_t OB_YB = 132 * MiB;
constexpr int LDY = 1536;
constexpr int CW_BAR = 4096;
constexpr int CW_QUEUE = 16384;

constexpr int RING_BYTES = 131072;
constexpr int LDSCTL_OFF = RING_BYTES;
constexpr int LDS_BYTES = RING_BYTES + 8192;

__device__ __forceinline__ int fresh_lane() { unsigned z = 0u; asm volatile("" : "+s"(z)); return (int)__builtin_amdgcn_mbcnt_hi(~0u, __builtin_amdgcn_mbcnt_lo(~0u, z)); }
__device__ __forceinline__ float bf_lo(unsigned w) { return __uint_as_float(w << 16); }
__device__ __forceinline__ float bf_hi(unsigned w) { return __uint_as_float(w & 0xffff0000u); }
__device__ __forceinline__ float bf2f(bf16_t b) { return __uint_as_float(((unsigned)b) << 16); }
__device__ __forceinline__ unsigned cvt_pk_bf16(float lo, float hi) { unsigned r; asm volatile("v_cvt_pk_bf16_f32 %0, %1, %2" : "=v"(r) : "v"(lo), "v"(hi)); return r; }
__device__ __forceinline__ float wave_sum(float v) {
#pragma unroll
    for (int o = 1; o < 64; o <<= 1) v += __shfl_xor(v, o);
    return v;
}
__device__ __forceinline__ float fast_exp(float x) { return __builtin_amdgcn_exp2f(x * 1.44269504089f); }
__device__ __forceinline__ float sigmoidf_(float x) { return __builtin_amdgcn_rcpf(1.0f + fast_exp(-x)); }

namespace pg8 {
constexpr int BM = 256, BK = 64, HALF = 128, HTB = HALF * BK * 2, STAGE_BYTES = 8 * HTB, NXCD = 8, WGM = 8;
__host__ __device__ __forceinline__ int lds_byte(int r, int c) { const int st = (r >> 4) * 2 + (c >> 5), rr = r & 15, cc = c & 31, ob = rr * 64 + cc * 2; return st * 1024 + (ob ^ (((ob >> 9) & 1) << 5)); }
__host__ __device__ __forceinline__ void stage_rc(int b, int& R, int& C) { const int st = b / 1024, sb = b % 1024, swz = sb ^ (((sb >> 9) & 1) << 5); R = (st >> 1) * 16 + swz / 64; C = (st & 1) * 32 + (swz % 64) / 2; }
__host__ __device__ __forceinline__ int perm32(int rho) { const int n = rho >> 4, i = rho & 15; return 8 * (i >> 2) + 4 * n + (i & 3); }

struct Unit { int pm, pn, z; };
struct Gemm { const char* A0; const char* A1; const char* A2; const char* Bt; size_t bzs; int lda, ldb, K; size_t azs;
    __device__ __forceinline__ const char* abase(int z) const { return azs ? A0 + (size_t)z * azs : (z == 0 ? A0 : (z == 1 ? A1 : A2)); } };
struct Sched {
    int nM, nN, nZ, nwg, G, c; bool flat; int pn0 = 0, gap_at = 1 << 30, gap = 0;
    __device__ __forceinline__ void init(int nM_, int nN_, int nZ_, int G_, int c_, bool flat_ = false) { nM = nM_; nN = nN_; nZ = nZ_; nwg = nM * nN; G = G_; c = c_; flat = flat_; }
    __device__ __forceinline__ bool next(int i, Unit& u) const {
        if (flat) { const long L = (long)i * G + c; if (L >= (long)nwg * nZ) return false; const int t = (int)(L / nZ); u.z = (int)(L - (long)t * nZ); u.pm = t / nN; u.pn = t - u.pm * nN; return true; }
        const int ti = i / nZ; u.z = i - ti * nZ;
        const long L = (long)ti * G + c; if (L >= nwg) return false;
        int wgid = (int)L; { const int q = nwg / NXCD, r = nwg % NXCD, xcd = wgid % NXCD, off = wgid / NXCD; wgid = (xcd < r ? xcd * (q + 1) : r * (q + 1) + (xcd - r) * q) + off; }
        const int nig = WGM * nN, gid = wgid / nig, fm = gid * WGM, gsz = (nM - fm) < WGM ? (nM - fm) : WGM;
        u.pm = fm + ((wgid % nig) % gsz); u.pn = (wgid % nig) / gsz; u.pn = pn0 + u.pn + (u.pn >= gap_at ? gap : 0); return true;
    }
};

template <class Epi, bool I8 = false>
__device__ __forceinline__ void gemm_phase(LAS unsigned char* lds, const Gemm g, const Sched& S, const Epi& E, int wave_id) {
    int tid_ = wave_id * 64 + fresh_lane(); asm volatile("" : "+v"(tid_));
    const int tid = tid_, wid = __builtin_amdgcn_readfirstlane(tid >> 6), lane = tid & 63, wr = wid >> 2, wc = wid & 3, fr = lane & 15, fq = lane >> 4;
    const int K = g.K, nt = K / BK;
    unsigned voffA[2], voffB[2];
#pragma unroll
    for (int i = 0; i < 2; ++i) { int R, C; stage_rc(tid * 16 + i * 8192, R, C); const int Rb = (R & ~31) + perm32(R & 31);
        voffA[i] = (unsigned)(R * g.lda + C) * 2u; voffB[i] = (unsigned)(Rb * g.ldb + C) * 2u; }
    const size_t kstep = (size_t)(BK * 2);
    const size_t hstepA = (size_t)HALF * g.lda * 2, hstepB = (size_t)HALF * g.ldb * 2;
    const size_t tstepA = 2 * hstepA, tstepB = 2 * hstepB;
    const unsigned ldsw = (unsigned)wid * 1024u;
    const int aoff = lds_byte(wr * 64 + fr, fq * 8), boff = lds_byte(wc * 32 + fr, fq * 8);
#define PG8_SA(b, h) (((b) * 2 + (h)) * HTB)
#define PG8_SB(b, h) ((4 + (b) * 2 + (h)) * HTB)
#define PG8_STAGE(bufoff, gbase, voff) do { _Pragma("unroll") for (int _i = 0; _i < 2; ++_i) \
        __builtin_amdgcn_global_load_lds((const unsigned*)((const char*)(gbase) + (voff)[_i]), (LAS unsigned*)(lds + (bufoff) + ldsw + _i * 8192), 16, 0, 0); } while (0)
#define PG8_LDA(dst, b, h) do { _Pragma("unroll") for (int m = 0; m < 4; ++m) _Pragma("unroll") for (int k = 0; k < 2; ++k) dst[m][k] = *(const LAS bf16x8*)(lds + PG8_SA(b, h) + aoff + m * 2048 + k * 1024); } while (0)
#define PG8_LDB(dst, b, h) do { _Pragma("unroll") for (int n = 0; n < 2; ++n) _Pragma("unroll") for (int k = 0; k < 2; ++k) dst[n][k] = *(const LAS bf16x8*)(lds + PG8_SB(b, h) + boff + n * 2048 + k * 1024); } while (0)
#define PG8_MMA(ai, bj, At, Bt) do { __builtin_amdgcn_s_setprio(1); _Pragma("unroll") for (int m = 0; m < 4; ++m) _Pragma("unroll") for (int n = 0; n < 2; ++n) _Pragma("unroll") for (int k = 0; k < 2; ++k) \
        acc[ai][bj][m][n] = I8 ? __builtin_bit_cast(f32x4, __builtin_amdgcn_mfma_i32_16x16x64_i8(__builtin_bit_cast(i32x4, Bt[n][k]), __builtin_bit_cast(i32x4, At[m][k]), __builtin_bit_cast(i32x4, acc[ai][bj][m][n]), 0, 0, 0)) \
                               : __builtin_amdgcn_mfma_f32_16x16x32_bf16(Bt[n][k], At[m][k], acc[ai][bj][m][n], 0, 0, 0); __builtin_amdgcn_s_setprio(0); } while (0)
#define PG8_WAIT_V(n) asm volatile("s_waitcnt vmcnt(" #n ")" ::: "memory")
#define PG8_WAIT_L(n) asm volatile("s_waitcnt lgkmcnt(" #n ")" ::: "memory")
#define PG8_BAR __builtin_amdgcn_s_barrier()
#define PG8_SCHED __builtin_amdgcn_sched_barrier(0)
    Unit cur, nxt; int ui = 0;
    if (!S.next(0, cur)) return;
    f32x4 acc[2][2][4][2];
#pragma unroll
    for (int a = 0; a < 2; ++a)
#pragma unroll
        for (int b = 0; b < 2; ++b)
#pragma unroll
            for (int m = 0; m < 4; ++m)
#pragma unroll
                for (int n = 0; n < 2; ++n) acc[a][b][m][n] = (f32x4){0.f, 0.f, 0.f, 0.f};
    bf16x8 At[4][2], B0[2][2], B1[2][2];
    const char* cA = g.abase(cur.z) + (size_t)cur.pm * tstepA; const char* cB = g.Bt + (size_t)cur.z * g.bzs + (size_t)cur.pn * tstepB;
    PG8_STAGE(PG8_SB(0, 0), cB, voffB); PG8_STAGE(PG8_SA(0, 0), cA, voffA); PG8_STAGE(PG8_SB(0, 1), cB + hstepB, voffB); PG8_STAGE(PG8_SA(0, 1), cA + hstepA, voffA);
    if (wr == 1) PG8_BAR;
    PG8_WAIT_V(4); PG8_BAR;
    PG8_STAGE(PG8_SB(1, 0), cB + kstep, voffB); PG8_STAGE(PG8_SA(1, 0), cA + kstep, voffA); PG8_STAGE(PG8_SB(1, 1), cB + hstepB + kstep, voffB);
    PG8_WAIT_V(6); PG8_BAR;
    for (;;) {
        const bool has_next = S.next(ui + 1, nxt);
        const char* nA = has_next ? g.abase(nxt.z) + (size_t)nxt.pm * tstepA : cA; const char* nB = has_next ? g.Bt + (size_t)nxt.z * g.bzs + (size_t)nxt.pn * tstepB : cB;
        for (int t = 0; t < nt; t += 2) {
            const bool last = (t == nt - 2);
            const char* a1 = cA + (size_t)(t + 1) * kstep;
            const char* a2 = last ? nA : cA + (size_t)(t + 2) * kstep; const char* b2 = last ? nB : cB + (size_t)(t + 2) * kstep;
            const char* a3 = a2 + kstep; const char* b3 = b2 + kstep;
            PG8_LDB(B0, 0, 0); PG8_SCHED; PG8_LDA(At, 0, 0); PG8_STAGE(PG8_SA(1, 1), a1 + hstepA, voffA);
            PG8_WAIT_L(8); PG8_BAR; PG8_WAIT_L(0); PG8_MMA(0, 0, At, B0); PG8_BAR; PG8_SCHED;
            PG8_LDB(B1, 0, 1); PG8_STAGE(PG8_SB(0, 0), b2, voffB);
            PG8_BAR; PG8_WAIT_L(0); PG8_MMA(0, 1, At, B1); PG8_BAR;
            PG8_LDA(At, 0, 1); PG8_STAGE(PG8_SA(0, 0), a2, voffA);
            PG8_BAR; PG8_WAIT_L(0); PG8_MMA(1, 0, At, B0); PG8_BAR; PG8_SCHED;
            PG8_STAGE(PG8_SB(0, 1), b2 + hstepB, voffB);
            PG8_WAIT_V(6); PG8_BAR; PG8_MMA(1, 1, At, B1); PG8_BAR;
            PG8_LDB(B0, 1, 0); PG8_SCHED; PG8_LDA(At, 1, 0); PG8_STAGE(PG8_SA(0, 1), a2 + hstepA, voffA);
            PG8_WAIT_L(8); PG8_BAR; PG8_WAIT_L(0); PG8_MMA(0, 0, At, B0); PG8_BAR; PG8_SCHED;
            PG8_LDB(B1, 1, 1); PG8_STAGE(PG8_SB(1, 0), b3, voffB);
            PG8_BAR; PG8_WAIT_L(0); PG8_MMA(0, 1, At, B1); PG8_BAR;
            PG8_LDA(At, 1, 1); PG8_STAGE(PG8_SA(1, 0), a3, voffA);
            PG8_BAR; PG8_WAIT_L(0); PG8_MMA(1, 0, At, B0); PG8_BAR; PG8_SCHED;
            PG8_STAGE(PG8_SB(1, 1), b3 + hstepB, voffB);
            PG8_WAIT_V(6); PG8_BAR; PG8_MMA(1, 1, At, B1); PG8_BAR;
        }
        const bool zero = E(acc, cur, wr, wc, fr, fq);
        if (!has_next) break;
        if (zero) {
#pragma unroll
            for (int a = 0; a < 2; ++a)
#pragma unroll
                for (int b = 0; b < 2; ++b)
#pragma unroll
                    for (int m = 0; m < 4; ++m)
#pragma unroll
                        for (int n = 0; n < 2; ++n) acc[a][b][m][n] = (f32x4){0.f, 0.f, 0.f, 0.f};
        }
        cur = nxt; cA = nA; cB = nB; ++ui;
    }
    PG8_WAIT_V(0);
    if (wr == 0) PG8_BAR;
    PG8_BAR;
#undef PG8_SA
#undef PG8_SB
#undef PG8_STAGE
#undef PG8_LDA
#undef PG8_LDB
#undef PG8_MMA
#undef PG8_WAIT_V
#undef PG8_WAIT_L
#undef PG8_BAR
#undef PG8_SCHED
}

__device__ __forceinline__ u32x4 pack8(const f32x4 a, const f32x4 b) { u32x4 w; w.x = cvt_pk_bf16(a[0], a[1]); w.y = cvt_pk_bf16(a[2], a[3]); w.z = cvt_pk_bf16(b[0], b[1]); w.w = cvt_pk_bf16(b[2], b[3]); return w; }

__device__ __forceinline__ void dequant_acc(f32x4 (&acc)[2][2][4][2], const Unit& u, int wr, int wc, int fr, int fq, const float* su, const float* sw) {
    const int row0 = u.pm * BM + wr * 64 + fr, col0 = u.pn * BM + wc * 32 + 8 * fq;
    f32x4 cs[2][2];
#pragma unroll
    for (int bj = 0; bj < 2; ++bj)
#pragma unroll
        for (int n = 0; n < 2; ++n) cs[bj][n] = *(const f32x4*)(sw + col0 + bj * HALF + 4 * n);
    float rsv[2][4];
#pragma unroll
    for (int ai = 0; ai < 2; ++ai)
#pragma unroll
        for (int m = 0; m < 4; ++m) rsv[ai][m] = su[row0 + ai * HALF + m * 16];
    asm volatile("" : "+v"(rsv[0][0]), "+v"(rsv[0][1]), "+v"(rsv[0][2]), "+v"(rsv[0][3]), "+v"(rsv[1][0]), "+v"(rsv[1][1]), "+v"(rsv[1][2]), "+v"(rsv[1][3]));
#pragma unroll
    for (int ai = 0; ai < 2; ++ai)
#pragma unroll
        for (int m = 0; m < 4; ++m) { const float rs = rsv[ai][m];
#pragma unroll
            for (int bj = 0; bj < 2; ++bj)
#pragma unroll
                for (int n = 0; n < 2; ++n) { const i32x4 iv = __builtin_bit_cast(i32x4, acc[ai][bj][m][n]);
                    acc[ai][bj][m][n] = (f32x4){(float)iv[0], (float)iv[1], (float)iv[2], (float)iv[3]} * cs[bj][n] * rs; } }
}
struct EpiBf16 {
    bf16_t* O; int ldc;
    __device__ __forceinline__ bool operator()(f32x4 (&acc)[2][2][4][2], const Unit& u, int wr, int wc, int fr, int fq) const {
        const int row0 = u.pm * BM + wr * 64 + fr, col0 = u.pn * BM + wc * 32 + 8 * fq;
#pragma unroll
        for (int ai = 0; ai < 2; ++ai)
#pragma unroll
            for (int m = 0; m < 4; ++m) { bf16_t* rowp = O + (size_t)(row0 + ai * HALF + m * 16) * ldc + col0;
#pragma unroll
                for (int bj = 0; bj < 2; ++bj) *(u32x4*)(rowp + bj * HALF) = pack8(acc[ai][bj][m][0], acc[ai][bj][m][1]); }
        return true;
    }
};
struct EpiSwiglu {
    bf16_t* O; int ldc; const float* su; const float* sw;
    __device__ __forceinline__ bool operator()(f32x4 (&acc)[2][2][4][2], const Unit& u, int wr, int wc, int fr, int fq) const {
        if (su) dequant_acc(acc, u, wr, wc, fr, fq, su, sw);
        const int row0 = u.pm * BM + wr * 64 + fr, col0 = u.pn * HALF + wc * 32 + 8 * fq;
#pragma unroll
        for (int ai = 0; ai < 2; ++ai)
#pragma unroll
            for (int m = 0; m < 4; ++m) { bf16_t* rowp = O + (size_t)(row0 + ai * HALF + m * 16) * ldc + col0;
                f32x4 o[2];
#pragma unroll
                for (int n = 0; n < 2; ++n)
#pragma unroll
                    for (int j = 0; j < 4; ++j) { const float gt = acc[ai][0][m][n][j], up = acc[ai][1][m][n][j]; o[n][j] = gt * sigmoidf_(gt) * up; }
                *(u32x4*)rowp = pack8(o[0], o[1]); }
        return true;
    }
};
struct EpiPartF32 {
    float* C; int ldc;
    __device__ __forceinline__ bool operator()(f32x4 (&acc)[2][2][4][2], const Unit& u, int wr, int wc, int fr, int fq) const {
        const int row0 = u.pm * BM + wr * 64 + fr, col0 = u.pn * BM + wc * 32 + 8 * fq;
        float* slab = C + (size_t)u.z * 256 * ldc;
#pragma unroll
        for (int ai = 0; ai < 2; ++ai)
#pragma unroll
            for (int m = 0; m < 4; ++m) { float* rowp = slab + (size_t)(row0 + ai * HALF + m * 16) * ldc + col0;
#pragma unroll
                for (int bj = 0; bj < 2; ++bj) { *(f32x4*)(rowp + bj * HALF) = acc[ai][bj][m][0]; *(f32x4*)(rowp + bj * HALF + 4) = acc[ai][bj][m][1]; } }
        return true;
    }
};
__device__ __forceinline__ size_t gt_off(int pm, int gn, int wr, int wc, int fr, int fq) { return ((size_t)pm * 12 + gn) * 65536 + (size_t)(((wr * 4 + wc) * 4 + fq) * 16 + fr) * 8; }
struct EpiWin {
    bf16_t* P; bf16_t* GT; bf16_t* KV; bf16_t* KI; const float* ctab; const float* stab; const float* su; const float* sw;
    __device__ __forceinline__ bool operator()(f32x4 (&acc)[2][2][4][2], const Unit& u, int wr, int wc, int fr, int fq) const {
        if (su) dequant_acc(acc, u, wr, wc, fr, fq, su, sw);
        const int row0 = u.pm * BM + wr * 64 + fr; const int pn = u.pn;
        const bool rope_tile = (pn >= 6 && pn <= 10);
        if (!rope_tile) {
            const int col0 = pn * BM + wc * 32 + 8 * fq;
            if (pn >= 19) {
                bf16_t* gt = GT + gt_off(u.pm, pn - 19, wr, wc, fr, fq);
#pragma unroll
                for (int ai = 0; ai < 2; ++ai)
#pragma unroll
                    for (int m = 0; m < 4; ++m)
#pragma unroll
                        for (int bj = 0; bj < 2; ++bj) { f32x4 v0 = acc[ai][bj][m][0], v1 = acc[ai][bj][m][1];
#pragma unroll
                            for (int j = 0; j < 4; ++j) { v0[j] = sigmoidf_(v0[j]); v1[j] = sigmoidf_(v1[j]); }
                            *(u32x4*)(gt + ((ai * 4 + m) * 2 + bj) * 4096) = pack8(v0, v1); }
                return true;
            }
#pragma unroll
            for (int ai = 0; ai < 2; ++ai)
#pragma unroll
                for (int m = 0; m < 4; ++m) { bf16_t* rowp = P + (size_t)(row0 + ai * HALF + m * 16) * LDP + col0;
#pragma unroll
                    for (int bj = 0; bj < 2; ++bj) *(u32x4*)(rowp + bj * HALF) = pack8(acc[ai][bj][m][0], acc[ai][bj][m][1]); }
            return true;
        }
        bool do_rope = true, skip = false; bf16_t* dbase; int dld, dcol;
        if (pn == 6 || pn == 7) { dbase = P; dld = LDP; dcol = PC_Q + (4 * (pn - 6) + wc) * 64; }
        else if (pn == 8) { dbase = KV; dld = 256; if (wc < 2) dcol = wc * 64; else { dcol = 128 + (wc - 2) * 64; do_rope = false; } }
        else if (pn == 9) { dbase = P; dld = LDP; dcol = PC_QI + wc * 64; }
        else { if (wc == 0) { dbase = KI; dld = 64; dcol = 0; } else if (wc == 1) { dbase = P; dld = LDP; dcol = PC_WI; do_rope = false; } else { dbase = P; dld = LDP; dcol = 0; skip = true; } }
        if (skip) return true;
#pragma unroll
        for (int am = 0; am < 4; ++am) { const int ai = am >> 1;
            f32x4 tc0[2], tc1[2], ts0[2], ts1[2];
            if (do_rope) {
#pragma unroll
                for (int mm = 0; mm < 2; ++mm) { const int t = (row0 + ai * HALF + (2 * (am & 1) + mm) * 16) % T; const float* cp = ctab + t * 32 + 8 * fq; const float* sp = stab + t * 32 + 8 * fq;
                    tc0[mm] = *(const f32x4*)cp; tc1[mm] = *(const f32x4*)(cp + 4); ts0[mm] = *(const f32x4*)sp; ts1[mm] = *(const f32x4*)(sp + 4); }
            }
#pragma unroll
            for (int mm = 0; mm < 2; ++mm) { const int m = 2 * (am & 1) + mm;
                const int rl = row0 + ai * HALF + m * 16;
                bf16_t* dp = dbase + (size_t)rl * dld + dcol + 8 * fq;
                f32x4 x1a = acc[ai][0][m][0], x1b = acc[ai][0][m][1], x2a = acc[ai][1][m][0], x2b = acc[ai][1][m][1];
                if (do_rope) {
                    const f32x4 c0 = tc0[mm], c1 = tc1[mm], s0 = ts0[mm], s1 = ts1[mm];
                    const f32x4 o1a = x1a * c0 - x2a * s0, o1b = x1b * c1 - x2b * s1, o2a = x1a * s0 + x2a * c0, o2b = x1b * s1 + x2b * c1;
                    *(u32x4*)dp = pack8(o1a, o1b); *(u32x4*)(dp + 32) = pack8(o2a, o2b);
                } else if (pn == 8) {
                    *(u32x4*)dp = pack8(x1a, x1b); *(u32x4*)(dp + 32) = pack8(x2a, x2b);
                } else {
                    *(u32x4*)dp = pack8(x1a, x1b);
                }
            }
        }
        return true;
    }
};
struct EpiGateSlab {
    const bf16_t* GT; float* C;
    __device__ __forceinline__ bool operator()(f32x4 (&acc)[2][2][4][2], const Unit& u, int wr, int wc, int fr, int fq) const {
        asm volatile("" : "+v"(fr));
        const int row0 = wr * 64 + fr, col0 = u.pn * BM + wc * 32 + 8 * fq; const int z = u.z;
        float* slab = C + (size_t)z * 256 * DM;
#pragma unroll
        for (int ai = 0; ai < 2; ++ai) {
            u32x4 gzv[4][2];
#pragma unroll
            for (int m = 0; m < 4; ++m)
#pragma unroll
                for (int bj = 0; bj < 2; ++bj) gzv[m][bj] = *(const u32x4*)(GT + gt_off(128, 4 * z + u.pn, wr, wc, fr, fq) + ((ai * 4 + m) * 2 + bj) * 4096);
#pragma unroll
            for (int m = 0; m < 4; ++m) { float* rowp = slab + (size_t)(row0 + ai * HALF + m * 16) * DM + col0;
#pragma unroll
                for (int bj = 0; bj < 2; ++bj) { const u32x4 gz = gzv[m][bj];
                    const f32x4 g0 = (f32x4){bf_lo(gz[0]), bf_hi(gz[0]), bf_lo(gz[1]), bf_hi(gz[1])}, g1 = (f32x4){bf_lo(gz[2]), bf_hi(gz[2]), bf_lo(gz[3]), bf_hi(gz[3])};
                    *(f32x4*)(rowp + bj * HALF) = acc[ai][bj][m][0] * g0; *(f32x4*)(rowp + bj * HALF + 4) = acc[ai][bj][m][1] * g1; } }
        }
        return true;
    }
};
struct EpiMerge {
    const bf16_t* GT; bf16_t* O; int nrows;
    __device__ __forceinline__ float rinv(float gnext) const { return __builtin_amdgcn_rcpf(fmaxf(gnext, 1e-12f)); }
    __device__ __forceinline__ bool operator()(f32x4 (&acc)[2][2][4][2], const Unit& u, int wr, int wc, int fr, int fq) const {
        const int row0 = u.pm * BM + wr * 64 + fr, col0 = u.pn * BM + wc * 32 + 8 * fq; const int z = u.z;
        const bf16_t* gz_ = GT + gt_off(u.pm, 4 * z + u.pn, wr, wc, fr, fq); const bf16_t* gn_ = GT + gt_off(u.pm, 4 * (z < 2 ? z + 1 : z) + u.pn, wr, wc, fr, fq);
#pragma unroll
        for (int ai = 0; ai < 2; ++ai) {
            u32x4 gzv[4][2], gnv[4][2];
#pragma unroll
            for (int m = 0; m < 4; ++m)
#pragma unroll
                for (int bj = 0; bj < 2; ++bj) { gzv[m][bj] = *(const u32x4*)(gz_ + ((ai * 4 + m) * 2 + bj) * 4096); gnv[m][bj] = *(const u32x4*)(gn_ + ((ai * 4 + m) * 2 + bj) * 4096); }
#pragma unroll
            for (int m = 0; m < 4; ++m) { const size_t rl = (size_t)(row0 + ai * HALF + m * 16);
#pragma unroll
                for (int bj = 0; bj < 2; ++bj) {
                    const u32x4 gz = gzv[m][bj], gn = gnv[m][bj];
                    float f[8];
                    if (z < 2) {
#pragma unroll
                        for (int j = 0; j < 4; ++j) { f[2 * j] = fmaxf(bf_lo(gz[j]), z ? 1e-12f : 0.f) * rinv(bf_lo(gn[j])); f[2 * j + 1] = fmaxf(bf_hi(gz[j]), z ? 1e-12f : 0.f) * rinv(bf_hi(gn[j])); }
                    } else {
#pragma unroll
                        for (int j = 0; j < 4; ++j) { f[2 * j] = fmaxf(bf_lo(gz[j]), 1e-12f); f[2 * j + 1] = fmaxf(bf_hi(gz[j]), 1e-12f); }
                    }
#pragma unroll
                    for (int j = 0; j < 4; ++j) { acc[ai][bj][m][0][j] *= f[j]; acc[ai][bj][m][1][j] *= f[4 + j]; }
                    if (z == 2 && (int)rl < nrows) *(u32x4*)(O + rl * DM + col0 + bj * HALF) = pack8(acc[ai][bj][m][0], acc[ai][bj][m][1]);
                } }
        }
        return z == 2;
    }
};
}

#define XB_TMO      128
#define XB_XCNT(j)  (256  + 64 * (j))
#define XB_XSUB(j)  (1280 + 64 * (j))
#define XB_XGEN(j)  (2304 + 64 * (j))
#define XB_TOP      3328
#define XB_TOPGEN   3392
#define XCD_BAR_WORDS 3456
#define XB_SPIN_CAP (1u << 22)
__device__ __forceinline__ unsigned xb_ld(unsigned* p)              { return __hip_atomic_load(p, __ATOMIC_RELAXED, __HIP_MEMORY_SCOPE_AGENT); }
__device__ __forceinline__ unsigned xb_add(unsigned* p, unsigned v) { return __hip_atomic_fetch_add(p, v, __ATOMIC_RELAXED, __HIP_MEMORY_SCOPE_AGENT); }
__device__ __forceinline__ unsigned xb_xcc_id() { return (unsigned)__builtin_amdgcn_s_getreg((3 << 11) | 20) & 0xFu; }
#define XB_SPIN(cond, bar) do { unsigned _sp = 0; while (cond) { __builtin_amdgcn_s_sleep(1); \
    if ((++_sp & 255u) == 0u) { if (xb_ld(&(bar)[XB_TMO])) break; if (_sp > XB_SPIN_CAP) { atomicAdd(&(bar)[XB_TMO], 1u); break; } } } } while (0)
struct XcdBarrier { unsigned* bar; unsigned x; volatile LAS unsigned* st; int wv; };
__device__ __forceinline__ XcdBarrier xcd_barrier_post(unsigned* bar, volatile LAS unsigned* st, int wv) {
    XcdBarrier b; b.bar = bar; b.x = xb_xcc_id(); b.st = st; b.wv = wv;
    if (wv == 0 && fresh_lane() == 0) (void)xb_add(&bar[XB_XCNT(b.x)], 1u);
    return b;
}
__device__ __forceinline__ void xcd_barrier_complete(unsigned* bar, unsigned x, unsigned& nloc, unsigned& nx) {
    const unsigned G = gridDim.x * gridDim.y * gridDim.z;
    unsigned sum, cnt, mine, sp = 0u;
    for (;;) {
        sum = 0u; cnt = 0u; mine = 0u;
#pragma unroll
        for (unsigned j = 0; j < 16; ++j) { const unsigned c = xb_ld(&bar[XB_XCNT(j)]); sum += c; cnt += (c > 0u) ? 1u : 0u; mine = (j == x) ? c : mine; }
        if (sum == G) break;
        __builtin_amdgcn_s_sleep(1);
        if ((++sp & 255u) == 0u) { if (xb_ld(&bar[XB_TMO])) break; if (sp > XB_SPIN_CAP) { atomicAdd(&bar[XB_TMO], 1u); break; } }
    }
    nloc = mine > 0u ? mine : 1u; nx = cnt > 0u ? cnt : 1u;
}
__device__ __forceinline__ void xcd_barrier(const XcdBarrier& b) {
    asm volatile("s_waitcnt vmcnt(0)" ::: "memory");
    __syncthreads();
    if (b.wv == 0 && fresh_lane() == 0) {
        unsigned* bar = b.bar;
        __builtin_amdgcn_s_waitcnt(0);
        unsigned nloc = b.st[0], nx = b.st[1];
        if (nloc == 0u) { xcd_barrier_complete(bar, b.x, nloc, nx); b.st[0] = nloc; b.st[1] = nx; }
        const unsigned old = xb_add(&bar[XB_XSUB(b.x)], 1u);
        const unsigned gen = old / nloc;
        if (old + 1u == (gen + 1u) * nloc) {
            __builtin_amdgcn_fence(__ATOMIC_RELEASE, "agent");
            asm volatile("s_waitcnt vmcnt(0)" ::: "memory");
            const unsigned og = xb_add(&bar[XB_TOP], 1u);
            const unsigned tg = og / nx;
            if (og + 1u == (tg + 1u) * nx) xb_add(&bar[XB_TOPGEN], 1u);
            else XB_SPIN(xb_ld(&bar[XB_TOPGEN]) == tg, bar);
            __builtin_amdgcn_fence(__ATOMIC_ACQUIRE, "agent");
            xb_add(&bar[XB_XGEN(b.x)], 1u);
            asm volatile("s_waitcnt vmcnt(0)" ::: "memory");
        } else {
            XB_SPIN(xb_ld(&bar[XB_XGEN(b.x)]) == gen, bar);
            __builtin_amdgcn_fence(__ATOMIC_ACQUIRE, "agent");
            asm volatile("s_waitcnt vmcnt(0)" ::: "memory");
        }
    }
    __syncthreads();
}

template <class Map>
__device__ __forceinline__ void cvt_item(const float* W, int K, int N, bf16_t* WT, LAS float* scr, int item, int lane, Map srccol) {
    asm volatile("" : "+v"(lane));
    const int nkb = K / 64, rb = item / nkb, kb = item % nkb, k0 = 64 * kb, r0 = 32 * rb;
    const int sc = srccol(r0 + (lane & 31)); const int scc = sc >= 0 ? sc : 0;
    { float v[32];
#pragma unroll
      for (int i = 0; i < 32; ++i) v[i] = W[(size_t)(k0 + 2 * i + (lane >> 5)) * N + scc];
#pragma unroll
      for (int i = 0; i < 32; ++i) { const int kk = 2 * i + (lane >> 5); scr[kk * 33 + (lane & 31)] = sc >= 0 ? v[i] : 0.f; } }
    asm volatile("s_waitcnt lgkmcnt(0)" ::: "memory");
    const int c = lane & 7;
#pragma unroll
    for (int j = 0; j < 4; ++j) { const int n = (lane >> 3) + 8 * j; const LAS float* s = scr + (8 * c) * 33 + n;
        u32x4 o; o.x = cvt_pk_bf16(s[0 * 33], s[1 * 33]); o.y = cvt_pk_bf16(s[2 * 33], s[3 * 33]); o.z = cvt_pk_bf16(s[4 * 33], s[5 * 33]); o.w = cvt_pk_bf16(s[6 * 33], s[7 * 33]);
        *(u32x4*)(WT + (size_t)(r0 + n) * K + k0 + 8 * c) = o; }
    asm volatile("s_waitcnt lgkmcnt(0)" ::: "memory");
}
__device__ __forceinline__ unsigned pack_i8x4(float a, float b, float c, float d);
template <class Map>
__device__ __forceinline__ void cvt8_item(const float* W, int K, int N, unsigned char* W8, float* sw, LAS float* scr, int item, int lane, Map srccol) {
    asm volatile("" : "+v"(lane));
    const int r0 = 32 * item, nkb = K / 64;
    const int sc = srccol(r0 + (lane & 31)); const int scc = sc >= 0 ? sc : 0;
    float am = 0.f;
#pragma unroll 1
    for (int kb = 0; kb < nkb; ++kb) { float v[32];
#pragma unroll
        for (int i = 0; i < 32; ++i) v[i] = W[(size_t)(64 * kb + 2 * i + (lane >> 5)) * N + scc];
#pragma unroll
        for (int i = 0; i < 32; ++i) am = fmaxf(am, fabsf(v[i])); }
    am = sc >= 0 ? am : 0.f;
    am = fmaxf(am, __shfl_xor(am, 32));
    const float inv = am > 0.f ? 127.0f / am : 0.f;
    if (lane < 32) sw[r0 + lane] = am * (1.0f / 127.0f);
#pragma unroll 1
    for (int kb = 0; kb < nkb; ++kb) { const int k0 = 64 * kb;
        { float v[32];
#pragma unroll
          for (int i = 0; i < 32; ++i) v[i] = W[(size_t)(k0 + 2 * i + (lane >> 5)) * N + scc];
#pragma unroll
          for (int i = 0; i < 32; ++i) { const int kk = 2 * i + (lane >> 5); scr[kk * 33 + (lane & 31)] = v[i] * inv; } }
        asm volatile("s_waitcnt lgkmcnt(0)" ::: "memory");
#pragma unroll
        for (int cc = 0; cc < 2; ++cc) { const int n = lane >> 1, c = (lane & 1) * 2 + cc; const LAS float* sp = scr + (16 * c) * 33 + n;
            u32x4 w;
#pragma unroll
            for (int d = 0; d < 4; ++d) w[d] = pack_i8x4(sp[(4 * d) * 33], sp[(4 * d + 1) * 33], sp[(4 * d + 2) * 33], sp[(4 * d + 3) * 33]);
            *(u32x4*)(W8 + (size_t)(r0 + n) * K + k0 + 16 * c) = w; }
        asm volatile("s_waitcnt lgkmcnt(0)" ::: "memory");
    }
}
__device__ __forceinline__ int map_gu(int r) { const int pn = r >> 8, bj = (r >> 7) & 1, p = r & 127; return bj * DFF + pn * 128 + p; }
__device__ __forceinline__ int map_id(int r) { return r; }
__device__ __forceinline__ int map_win(int r) {
    if (r < 1536) return r;
    if (r < 2816) {
        const int pn = r >> 8, bj = (r >> 7) & 1, p = r & 127, hl = p >> 5, j = p & 31;
        if (pn == 6 || pn == 7) return SC_Q + (4 * (pn - 6) + hl) * 64 + bj * 32 + j;
        if (pn == 8) return hl < 2 ? SC_K + hl * 64 + bj * 32 + j : SC_V + (hl - 2) * 64 + bj * 32 + j;
        if (pn == 9) return SC_QI + hl * 64 + bj * 32 + j;
        if (hl == 0) return SC_KI + bj * 32 + j;
        if (hl == 1 && bj == 0) { if (j < 4) return SC_WI + j; if (j < 8) return SC_MI + (j - 4); if (j < 12) return SC_MF + (j - 8); }
        return -1;
    }
    if (r < 4864) return SC_MQ + (r - 2816);
    return SC_GT + (r - 4864);
}

__device__ __forceinline__ f32x4 ld_h4(const hres_t* row, int idx) { return __builtin_convertvector(((const h16x4*)row)[idx], f32x4); }
__device__ __forceinline__ void st_h4(hres_t* row, int idx, f32x4 v) { ((h16x4*)row)[idx] = __builtin_convertvector(v, h16x4); }
__device__ __forceinline__ unsigned pack_i8x4(float a, float b, float c, float d) {
    const int q0 = (int)__builtin_rintf(a), q1 = (int)__builtin_rintf(b), q2 = (int)__builtin_rintf(c), q3 = (int)__builtin_rintf(d);
    return ((unsigned)q0 & 255u) | (((unsigned)q1 & 255u) << 8) | (((unsigned)q2 & 255u) << 16) | ((unsigned)q3 << 24);
}
__device__ __forceinline__ void store_row_bf16(const f32x4 (&o)[4], bf16_t* urow, int lane) {
#pragma unroll
    for (int j = 0; j < 4; ++j) { u32x2 w; w.x = cvt_pk_bf16(o[j][0], o[j][1]); w.y = cvt_pk_bf16(o[j][2], o[j][3]); ((u32x2*)urow)[lane + 64 * j] = w; }
}
__device__ __forceinline__ void store_row_i8(const f32x4 (&o)[4], unsigned char* u8row, float* su_r, int lane) {
    float am = 0.f;
#pragma unroll
    for (int j = 0; j < 4; ++j) am = fmaxf(fmaxf(am, fmaxf(fabsf(o[j][0]), fabsf(o[j][1]))), fmaxf(fabsf(o[j][2]), fabsf(o[j][3])));
#pragma unroll
    for (int of = 1; of < 64; of <<= 1) am = fmaxf(am, __shfl_xor(am, of));
    const float inv = am > 0.f ? 127.0f / am : 0.f;
#pragma unroll
    for (int j = 0; j < 4; ++j) ((unsigned*)u8row)[lane + 64 * j] = pack_i8x4(o[j][0] * inv, o[j][1] * inv, o[j][2] * inv, o[j][3] * inv);
    if (lane == 0) *su_r = am * (1.0f / 127.0f);
}
__device__ __forceinline__ void norm_row(const bf16_t* yrow, const float* yf32  , int nz, hres_t* hrow, unsigned char* urow, float* su_r, bf16_t* ub  , const float* ga, const float* gb, float cscale, int lane) {
    asm volatile("" : "+v"(lane));
    const u32x2* yr = (const u32x2*)yrow + lane;
    f32x4 yv[4]; float ss = 0.f;
#pragma unroll
    for (int j = 0; j < 4; ++j) { if (yf32) { const f32x4* yp = (const f32x4*)yf32 + lane + 64 * j; f32x4 sl[11];
#pragma unroll
            for (int z = 0; z < 11; ++z) sl[z] = yp[(size_t)(z < nz ? z : 0) * 256 * DM / 4];
            f32x4 acc = sl[0];
#pragma unroll
            for (int z = 1; z < 11; ++z) acc += (z < nz) ? sl[z] : (f32x4){0.f, 0.f, 0.f, 0.f}; yv[j] = acc; } else { const u32x2 w = yr[64 * j]; yv[j] = (f32x4){bf_lo(w.x), bf_hi(w.x), bf_lo(w.y), bf_hi(w.y)}; } ss += (yv[j][0] * yv[j][0] + yv[j][1] * yv[j][1]) + (yv[j][2] * yv[j][2] + yv[j][3] * yv[j][3]); }
    const float rs = 1.0f / sqrtf(wave_sum(ss) * (1.0f / DM) + EPS);
    f32x4 hn[4]; float s2 = 0.f;
#pragma unroll
    for (int j = 0; j < 4; ++j) { const f32x4 g4 = ((const f32x4*)ga)[lane + 64 * j]; const h16x4 hh = __builtin_convertvector(ld_h4(hrow, lane + 64 * j) + cscale * (yv[j] * rs * g4), h16x4); ((h16x4*)hrow)[lane + 64 * j] = hh; hn[j] = __builtin_convertvector(hh, f32x4);
        s2 += (hn[j][0] * hn[j][0] + hn[j][1] * hn[j][1]) + (hn[j][2] * hn[j][2] + hn[j][3] * hn[j][3]); }
    const float rs2 = 1.0f / sqrtf(wave_sum(s2) * (1.0f / DM) + EPS);
    f32x4 ov[4];
#pragma unroll
    for (int j = 0; j < 4; ++j) { const f32x4 g4 = ((const f32x4*)gb)[lane + 64 * j]; ov[j] = hn[j] * rs2 * g4; }
    store_row_i8(ov, urow, su_r, lane);
    if (ub) store_row_bf16(ov, ub, lane);
}
__device__ __forceinline__ void norm_rows2(const bf16_t* y0, const bf16_t* y1, hres_t* h0, hres_t* h1, unsigned char* u0, unsigned char* u1, float* su0, float* su1, bf16_t* ub0, bf16_t* ub1  , bool has1, const float* ga, const float* gb, float cscale, int lane) {
    asm volatile("" : "+v"(lane));
    f32x4 yv[2][4], hv[2][4];
#pragma unroll
    for (int j = 0; j < 4; ++j) { const u32x2 w = ((const u32x2*)y0)[lane + 64 * j]; yv[0][j] = (f32x4){bf_lo(w.x), bf_hi(w.x), bf_lo(w.y), bf_hi(w.y)}; hv[0][j] = ld_h4(h0, lane + 64 * j); }
    if (has1) {
#pragma unroll
        for (int j = 0; j < 4; ++j) { const u32x2 w = ((const u32x2*)y1)[lane + 64 * j]; yv[1][j] = (f32x4){bf_lo(w.x), bf_hi(w.x), bf_lo(w.y), bf_hi(w.y)}; hv[1][j] = ld_h4(h1, lane + 64 * j); }
    } else {
#pragma unroll
        for (int j = 0; j < 4; ++j) { yv[1][j] = (f32x4){0.f, 0.f, 0.f, 0.f}; hv[1][j] = yv[1][j]; }
    }
    float ss0 = 0.f, ss1 = 0.f;
#pragma unroll
    for (int j = 0; j < 4; ++j) { ss0 += (yv[0][j][0] * yv[0][j][0] + yv[0][j][1] * yv[0][j][1]) + (yv[0][j][2] * yv[0][j][2] + yv[0][j][3] * yv[0][j][3]);
                                  ss1 += (yv[1][j][0] * yv[1][j][0] + yv[1][j][1] * yv[1][j][1]) + (yv[1][j][2] * yv[1][j][2] + yv[1][j][3] * yv[1][j][3]); }
#pragma unroll
    for (int o = 1; o < 64; o <<= 1) { ss0 += __shfl_xor(ss0, o); ss1 += __shfl_xor(ss1, o); }
    const float rs0 = 1.0f / sqrtf(ss0 * (1.0f / DM) + EPS), rs1 = 1.0f / sqrtf(ss1 * (1.0f / DM) + EPS);
    float s20 = 0.f, s21 = 0.f;
#pragma unroll
    for (int j = 0; j < 4; ++j) { const f32x4 g4 = ((const f32x4*)ga)[lane + 64 * j];
        const h16x4 hh0 = __builtin_convertvector(hv[0][j] + cscale * (yv[0][j] * rs0 * g4), h16x4), hh1 = __builtin_convertvector(hv[1][j] + cscale * (yv[1][j] * rs1 * g4), h16x4);
        ((h16x4*)h0)[lane + 64 * j] = hh0; if (has1) ((h16x4*)h1)[lane + 64 * j] = hh1;
        hv[0][j] = __builtin_convertvector(hh0, f32x4); hv[1][j] = __builtin_convertvector(hh1, f32x4);
        s20 += (hv[0][j][0] * hv[0][j][0] + hv[0][j][1] * hv[0][j][1]) + (hv[0][j][2] * hv[0][j][2] + hv[0][j][3] * hv[0][j][3]);
        s21 += (hv[1][j][0] * hv[1][j][0] + hv[1][j][1] * hv[1][j][1]) + (hv[1][j][2] * hv[1][j][2] + hv[1][j][3] * hv[1][j][3]); }
#pragma unroll
    for (int o = 1; o < 64; o <<= 1) { s20 += __shfl_xor(s20, o); s21 += __shfl_xor(s21, o); }
    const float r20 = 1.0f / sqrtf(s20 * (1.0f / DM) + EPS), r21 = 1.0f / sqrtf(s21 * (1.0f / DM) + EPS);
    f32x4 ov0[4], ov1[4];
#pragma unroll
    for (int j = 0; j < 4; ++j) { const f32x4 g4 = ((const f32x4*)gb)[lane + 64 * j]; ov0[j] = hv[0][j] * r20 * g4; ov1[j] = hv[1][j] * r21 * g4; }
    store_row_i8(ov0, u0, su0, lane);
    if (has1) store_row_i8(ov1, u1, su1, lane);
    if (ub0) { store_row_bf16(ov0, ub0, lane); if (has1) store_row_bf16(ov1, ub1, lane); }
}
__device__ __forceinline__ void nr_load(u32x2 (&yv)[2][4], h16x4 (&hv)[2][4], const bf16_t* Y, const hres_t* H, int r, int NGW, int lane) {
    const int r1 = r + NGW; const size_t o0 = (size_t)r * DM, o1 = (size_t)(r1 < MT ? r1 : r) * DM;
#pragma unroll
    for (int j = 0; j < 4; ++j) { yv[0][j] = ((const u32x2*)(Y + o0))[lane + 64 * j]; hv[0][j] = ((const h16x4*)(H + o0))[lane + 64 * j]; }
#pragma unroll
    for (int j = 0; j < 4; ++j) { yv[1][j] = ((const u32x2*)(Y + o1))[lane + 64 * j]; hv[1][j] = ((const h16x4*)(H + o1))[lane + 64 * j]; }
}
__device__ __forceinline__ unsigned pack_i8x4_magic(float a, float b, float c, float d, float inv) {
    const float MG = 12582912.0f;
    const unsigned qa = __float_as_uint(__builtin_fmaf(a, inv, MG)), qb = __float_as_uint(__builtin_fmaf(b, inv, MG)), qc = __float_as_uint(__builtin_fmaf(c, inv, MG)), qd = __float_as_uint(__builtin_fmaf(d, inv, MG));
    const unsigned ab = __builtin_amdgcn_perm(qb, qa, 0x0c0c0400u), cd = __builtin_amdgcn_perm(qd, qc, 0x0c0c0400u);
    return __builtin_amdgcn_perm(cd, ab, 0x05040100u);
}
__device__ __forceinline__ void nr_finish(const u32x2 (&yr)[2][4], const h16x4 (&hr)[2][4], hres_t* H, unsigned char* U8, float* SU, bf16_t* UB, const f32x4 (&gA)[4], const f32x4 (&gB)[4], float cscale, int r, int NGW, int lane) {
    const int r1 = r + NGW; const bool has1 = r1 < MT; const size_t o[2] = {(size_t)r * DM, (size_t)(has1 ? r1 : r) * DM};
    f32x4 yv[2][4]; float ss[2] = {0.f, 0.f};
#pragma unroll
    for (int q = 0; q < 2; ++q)
#pragma unroll
        for (int j = 0; j < 4; ++j) { const u32x2 w = yr[q][j]; yv[q][j] = (f32x4){bf_lo(w.x), bf_hi(w.x), bf_lo(w.y), bf_hi(w.y)};
            ss[q] += (yv[q][j][0] * yv[q][j][0] + yv[q][j][1] * yv[q][j][1]) + (yv[q][j][2] * yv[q][j][2] + yv[q][j][3] * yv[q][j][3]); }
#pragma unroll
    for (int of = 1; of < 64; of <<= 1) { ss[0] += __shfl_xor(ss[0], of); ss[1] += __shfl_xor(ss[1], of); }
    const float rs[2] = {cscale * __builtin_amdgcn_rsqf(ss[0] * (1.0f / DM) + EPS), cscale * __builtin_amdgcn_rsqf(ss[1] * (1.0f / DM) + EPS)};
    f32x4 hv[2][4]; float s2[2] = {0.f, 0.f};
#pragma unroll
    for (int j = 0; j < 4; ++j) { const f32x4 g4 = gA[j];
#pragma unroll
        for (int q = 0; q < 2; ++q) { const h16x4 hh = __builtin_convertvector(__builtin_convertvector(hr[q][j], f32x4) + (yv[q][j] * g4) * rs[q], h16x4);
            if (q == 0 || has1) ((h16x4*)(H + o[q]))[lane + 64 * j] = hh;
            hv[q][j] = __builtin_convertvector(hh, f32x4);
            s2[q] += (hv[q][j][0] * hv[q][j][0] + hv[q][j][1] * hv[q][j][1]) + (hv[q][j][2] * hv[q][j][2] + hv[q][j][3] * hv[q][j][3]); } }
#pragma unroll
    for (int of = 1; of < 64; of <<= 1) { s2[0] += __shfl_xor(s2[0], of); s2[1] += __shfl_xor(s2[1], of); }
    const float r2[2] = {__builtin_amdgcn_rsqf(s2[0] * (1.0f / DM) + EPS), __builtin_amdgcn_rsqf(s2[1] * (1.0f / DM) + EPS)};
    float am[2] = {0.f, 0.f};
#pragma unroll
    for (int j = 0; j < 4; ++j) { const f32x4 g4 = gB[j];
#pragma unroll
        for (int q = 0; q < 2; ++q) { hv[q][j] = (hv[q][j] * g4) * r2[q];
            am[q] = fmaxf(fmaxf(am[q], fmaxf(fabsf(hv[q][j][0]), fabsf(hv[q][j][1]))), fmaxf(fabsf(hv[q][j][2]), fabsf(hv[q][j][3]))); } }
#pragma unroll
    for (int of = 1; of < 64; of <<= 1) { am[0] = fmaxf(am[0], __shfl_xor(am[0], of)); am[1] = fmaxf(am[1], __shfl_xor(am[1], of)); }
#pragma unroll
    for (int q = 0; q < 2; ++q) {
        if (q == 1 && !has1) break;
        const float inv = am[q] > 0.f ? 127.0f * __builtin_amdgcn_rcpf(am[q]) : 0.f;
#pragma unroll
        for (int j = 0; j < 4; ++j) ((unsigned*)(U8 + o[q]))[lane + 64 * j] = pack_i8x4_magic(hv[q][j][0], hv[q][j][1], hv[q][j][2], hv[q][j][3], inv);
        if (lane == 0) SU[q ? r1 : r] = am[q] * (1.0f / 127.0f);
        if (UB) {
#pragma unroll
            for (int j = 0; j < 4; ++j) { u32x2 w; w.x = cvt_pk_bf16(hv[q][j][0], hv[q][j][1]); w.y = cvt_pk_bf16(hv[q][j][2], hv[q][j][3]); ((u32x2*)(UB + o[q]))[lane + 64 * j] = w; }
        }
    }
}
__device__ __forceinline__ void norm_pass(const bf16_t* Y, hres_t* H, unsigned char* U8, float* SU, bf16_t* UB  , const float* ga, const float* gb, float cscale, int gw, int NGW, int lane) {
    asm volatile("" : "+v"(lane));
    u32x2 yA[2][4], yB[2][4]; h16x4 hA[2][4], hB[2][4];
    f32x4 gA[4], gB[4];
#pragma unroll
    for (int j = 0; j < 4; ++j) { gA[j] = ((const f32x4*)ga)[lane + 64 * j]; gB[j] = ((const f32x4*)gb)[lane + 64 * j]; }
    int r = gw;
    if (r >= MT) return;
    nr_load(yA, hA, Y, H, r, NGW, lane);
#pragma unroll 1
    for (;;) {
        const int rn = r + 2 * NGW;
        nr_load(yB, hB, Y, H, rn < MT ? rn : r, NGW, lane);
        nr_finish(yA, hA, H, U8, SU, UB, gA, gB, cscale, r, NGW, lane);
        if (rn >= MT) break;
        r = rn + 2 * NGW;
        nr_load(yA, hA, Y, H, r < MT ? r : rn, NGW, lane);
        nr_finish(yB, hB, H, U8, SU, UB, gA, gB, cscale, rn, NGW, lane);
        if (r >= MT) break;
    }
}
__device__ __forceinline__ void init_load(f32x4 (&sv)[2][4], const float* x, const float* meta, int r, int NGW, int lane) {
#pragma unroll
    for (int q = 0; q < 2; ++q) { int rr = r + q * NGW; rr = rr < M ? rr : r; const int b = rr / T, t = rr - b * T;
        const float* src = t < NMETA ? meta + (size_t)t * DM : x + ((size_t)b * SEQ + (t - NMETA)) * DM;
#pragma unroll
        for (int j = 0; j < 4; ++j) sv[q][j] = ((const f32x4*)src)[lane + 64 * j]; }
}
__device__ __forceinline__ void init_finish(const f32x4 (&sv)[2][4], hres_t* H, unsigned char* U8, float* SU, const f32x4 (&gB)[4], int r, int NGW, int lane) {
    const int r1 = r + NGW; const bool has1 = r1 < M; const size_t o[2] = {(size_t)r * DM, (size_t)(has1 ? r1 : r) * DM};
    f32x4 hv[2][4]; float s2[2] = {0.f, 0.f};
#pragma unroll
    for (int q = 0; q < 2; ++q)
#pragma unroll
        for (int j = 0; j < 4; ++j) { const h16x4 hh = __builtin_convertvector(sv[q][j], h16x4); if (q == 0 || has1) ((h16x4*)(H + o[q]))[lane + 64 * j] = hh; hv[q][j] = __builtin_convertvector(hh, f32x4);
            s2[q] += (hv[q][j][0] * hv[q][j][0] + hv[q][j][1] * hv[q][j][1]) + (hv[q][j][2] * hv[q][j][2] + hv[q][j][3] * hv[q][j][3]); }
#pragma unroll
    for (int of = 1; of < 64; of <<= 1) { s2[0] += __shfl_xor(s2[0], of); s2[1] += __shfl_xor(s2[1], of); }
    const float r2[2] = {__builtin_amdgcn_rsqf(s2[0] * (1.0f / DM) + EPS), __builtin_amdgcn_rsqf(s2[1] * (1.0f / DM) + EPS)};
    float am[2] = {0.f, 0.f};
#pragma unroll
    for (int j = 0; j < 4; ++j)
#pragma unroll
        for (int q = 0; q < 2; ++q) { hv[q][j] = (hv[q][j] * gB[j]) * r2[q];
            am[q] = fmaxf(fmaxf(am[q], fmaxf(fabsf(hv[q][j][0]), fabsf(hv[q][j][1]))), fmaxf(fabsf(hv[q][j][2]), fabsf(hv[q][j][3]))); }
#pragma unroll
    for (int of = 1; of < 64; of <<= 1) { am[0] = fmaxf(am[0], __shfl_xor(am[0], of)); am[1] = fmaxf(am[1], __shfl_xor(am[1], of)); }
#pragma unroll
    for (int q = 0; q < 2; ++q) {
        if (q == 1 && !has1) break;
        const float inv = am[q] > 0.f ? 127.0f * __builtin_amdgcn_rcpf(am[q]) : 0.f;
#pragma unroll
        for (int j = 0; j < 4; ++j) ((unsigned*)(U8 + o[q]))[lane + 64 * j] = pack_i8x4_magic(hv[q][j][0], hv[q][j][1], hv[q][j][2], hv[q][j][3], inv);
        if (lane == 0) SU[q ? r1 : r] = am[q] * (1.0f / 127.0f);
    }
}
__device__ __forceinline__ void init_pass(const float* x, const float* meta, hres_t* H, unsigned char* U8, float* SU, const float* gb, int gw, int NGW, int lane) {
    asm volatile("" : "+v"(lane));
    f32x4 sA[2][4], sB[2][4], gB[4];
#pragma unroll
    for (int j = 0; j < 4; ++j) gB[j] = ((const f32x4*)gb)[lane + 64 * j];
    int r = gw;
    if (r >= M) return;
    init_load(sA, x, meta, r, NGW, lane);
#pragma unroll 1
    for (;;) {
        const int rn = r + 2 * NGW;
        init_load(sB, x, meta, rn < M ? rn : r, NGW, lane);
        init_finish(sA, H, U8, SU, gB, r, NGW, lane);
        if (rn >= M) break;
        r = rn + 2 * NGW;
        init_load(sA, x, meta, r < M ? r : rn, NGW, lane);
        init_finish(sB, H, U8, SU, gB, rn, NGW, lane);
        if (r >= M) break;
    }
}
__device__ __forceinline__ void init_row(const float* src, hres_t* hrow, unsigned char* urow, float* su_r, const float* gb, int lane) {
    asm volatile("" : "+v"(lane));
    const f32x4* sr = (const f32x4*)src + lane;
    f32x4 hn[4]; float s2 = 0.f;
#pragma unroll
    for (int j = 0; j < 4; ++j) { const h16x4 hh = __builtin_convertvector(sr[64 * j], h16x4); ((h16x4*)hrow)[lane + 64 * j] = hh; hn[j] = __builtin_convertvector(hh, f32x4); s2 += (hn[j][0] * hn[j][0] + hn[j][1] * hn[j][1]) + (hn[j][2] * hn[j][2] + hn[j][3] * hn[j][3]); }
    const float rs2 = 1.0f / sqrtf(wave_sum(s2) * (1.0f / DM) + EPS);
    f32x4 ov[4];
#pragma unroll
    for (int j = 0; j < 4; ++j) { const f32x4 g4 = ((const f32x4*)gb)[lane + 64 * j]; ov[j] = hn[j] * rs2 * g4; }
    store_row_i8(ov, urow, su_r, lane);
}

#define DPP_STEP_U(v, ctrl, rmask) ((unsigned)__builtin_amdgcn_update_dpp(0, (int)(v), ctrl, rmask, 0xf, false))
#define DPP_STEP_F(v, ctrl, rmask) __int_as_float(__builtin_amdgcn_update_dpp(0, __float_as_int(v), ctrl, rmask, 0xf, false))
#define DPP_STEP_M(v, ctrl, rmask) __int_as_float(__builtin_amdgcn_update_dpp((int)0xff800000, __float_as_int(v), ctrl, rmask, 0xf, false))
__device__ __forceinline__ unsigned wave_incl_sum_u(unsigned v, int) {
    v += DPP_STEP_U(v, 0x111, 0xf); v += DPP_STEP_U(v, 0x112, 0xf); v += DPP_STEP_U(v, 0x114, 0xf); v += DPP_STEP_U(v, 0x118, 0xf);
    v += DPP_STEP_U(v, 0x142, 0xa); v += DPP_STEP_U(v, 0x143, 0xc);
    return v;
}
__device__ __forceinline__ float wave_incl_sum(float v, int) {
    v += DPP_STEP_F(v, 0x111, 0xf); v += DPP_STEP_F(v, 0x112, 0xf); v += DPP_STEP_F(v, 0x114, 0xf); v += DPP_STEP_F(v, 0x118, 0xf);
    v += DPP_STEP_F(v, 0x142, 0xa); v += DPP_STEP_F(v, 0x143, 0xc);
    return v;
}
__device__ __forceinline__ float wave_incl_max(float v, int) {
    v = fmaxf(v, DPP_STEP_M(v, 0x111, 0xf)); v = fmaxf(v, DPP_STEP_M(v, 0x112, 0xf)); v = fmaxf(v, DPP_STEP_M(v, 0x114, 0xf)); v = fmaxf(v, DPP_STEP_M(v, 0x118, 0xf));
    v = fmaxf(v, DPP_STEP_M(v, 0x142, 0xa)); v = fmaxf(v, DPP_STEP_M(v, 0x143, 0xc));
    return v;
}
__device__ __forceinline__ float wave_max(float v) {
#pragma unroll
    for (int o = 1; o < 64; o <<= 1) v = fmaxf(v, __shfl_xor(v, o));
    return v;
}
__device__ __forceinline__ unsigned keep_low(unsigned x, unsigned n) { unsigned cnt = __popc(x); while (cnt > n) { x &= ~(0x80000000u >> __clz(x)); --cnt; } return x; }
#define LDSW() asm volatile("s_waitcnt lgkmcnt(0)" ::: "memory")

__device__ __forceinline__ void conv_item(const bf16_t* P, bf16_t* YB, const float* wconv  , int bl, int ci, int tid) {
    asm volatile("" : "+v"(tid));
    const int ch = (tid & 63) * 8;
    const f32x4 w0a = *(const f32x4*)(wconv + ch), w0b = *(const f32x4*)(wconv + ch + 4), w1a = *(const f32x4*)(wconv + 512 + ch), w1b = *(const f32x4*)(wconv + 512 + ch + 4),
                w2a = *(const f32x4*)(wconv + 1024 + ch), w2b = *(const f32x4*)(wconv + 1024 + ch + 4);
#pragma unroll 1
    for (int i0 = 0; i0 < 16; i0 += 4) {
        u32x4 xb[4], x0[4], c0[4], x1[4], c1[4], x2[4], c2[4]; int tt[4];
#pragma unroll
        for (int u = 0; u < 4; ++u) { const int t = 128 * ci + 8 * (i0 + u) + (tid >> 6); tt[u] = t; const int tc = t < T ? t : T - 1;
            const bf16_t* row = P + (size_t)(bl * T + tc) * LDP;
            xb[u] = *(const u32x4*)(row + PC_CB + ch); x0[u] = *(const u32x4*)(row + PC_CX + ch); c0[u] = *(const u32x4*)(row + PC_CC + ch);
            const bf16_t* r1 = tc >= 1 ? row - LDP : row; const bf16_t* r2 = tc >= 2 ? row - 2 * LDP : row;
            x1[u] = *(const u32x4*)(r1 + PC_CX + ch); c1[u] = *(const u32x4*)(r1 + PC_CC + ch); x2[u] = *(const u32x4*)(r2 + PC_CX + ch); c2[u] = *(const u32x4*)(r2 + PC_CC + ch); }
#pragma unroll
        for (int u = 0; u < 4; ++u) { const int t = tt[u];
            float o[8];
#pragma unroll
            for (int j = 0; j < 8; ++j) { const int d = j >> 1; const bool hi = j & 1;
                const float u0 = (hi ? bf_hi(x0[u][d]) : bf_lo(x0[u][d])) * (hi ? bf_hi(c0[u][d]) : bf_lo(c0[u][d]));
                const float u1 = t >= 1 ? (hi ? bf_hi(x1[u][d]) : bf_lo(x1[u][d])) * (hi ? bf_hi(c1[u][d]) : bf_lo(c1[u][d])) : 0.f;
                const float u2 = t >= 2 ? (hi ? bf_hi(x2[u][d]) : bf_lo(x2[u][d])) * (hi ? bf_hi(c2[u][d]) : bf_lo(c2[u][d])) : 0.f;
                const float w0 = j < 4 ? w0a[j] : w0b[j - 4], w1 = j < 4 ? w1a[j] : w1b[j - 4], w2 = j < 4 ? w2a[j] : w2b[j - 4];
                const float cbv = hi ? bf_hi(xb[u][d]) : bf_lo(xb[u][d]);
                o[j] = cbv * (w0 * u2 + w1 * u1 + w2 * u0); }
            u32x4 w; w.x = cvt_pk_bf16(o[0], o[1]); w.y = cvt_pk_bf16(o[2], o[3]); w.z = cvt_pk_bf16(o[4], o[5]); w.w = cvt_pk_bf16(o[6], o[7]);
            if (t < T) *(u32x4*)(YB + (size_t)(bl * T + t) * LDY + ch) = w; }
    }
}

constexpr int SA_HIST = 0, SA_GT = 16384, SA_EQ = 24832, SA_SEL = 33280  , SA_MM = 33792  , SA_FSEL = 36864  , SA_LISTS = 36864  , SA_SPS = 53248  , DENSE_QB = 128, SA_SP = 53248  , SA_CAND = SA_SP, SA_CAP = 512;
#ifndef PROBE_ID
#define PROBE_ID 0
#endif
#define SEC_T0(k) unsigned long long st0_##k = 0; if ((PROBE_ID >> (k)) & 1) st0_##k = __builtin_amdgcn_s_memrealtime();
#define SEC_T1(k) if ((PROBE_ID >> (k)) & 1) { const unsigned long long t1_ = __builtin_amdgcn_s_memrealtime(); const unsigned long long d_ = t1_ - st0_##k; while (__builtin_amdgcn_s_memrealtime() - t1_ < d_) __builtin_amdgcn_s_sleep(4); }
__device__ __forceinline__ unsigned f2key(float f) { const unsigned b = __float_as_uint(f); return b ^ ((unsigned)((int)b >> 31) | 0x80000000u); }
__device__ __forceinline__ float key2f(unsigned k) { return __uint_as_float(k ^ ((k >> 31) ? 0x80000000u : 0xFFFFFFFFu)); }
__device__ __forceinline__ void selattn_item(LAS unsigned char* lds, const bf16_t* P, bf16_t* YB, const bf16_t* KV, const bf16_t* KI, int bl, int qb, int tid, int lane, int wave) {
    asm volatile("" : "+v"(tid)); lane = tid & 63;
    const int t0 = qb * 16, nkt = qb + 1; const size_t rowbase = (size_t)bl * T;
    const int c16 = lane & 15, g4 = lane >> 4;
    LAS unsigned* hist = (LAS unsigned*)(lds + SA_HIST);
    LAS unsigned* selp = (LAS unsigned*)(lds + SA_SEL);
    LAS float* smm = (LAS float*)(lds + SA_MM);
    const bool selall = (qb < 16);
    const float NINF = -__builtin_inff();
    for (int i = tid; i < 2 * 16 * 132; i += 512) ((LAS unsigned*)(lds + SA_GT))[i] = 0u;
    for (int i = tid; i < 4096; i += 512) hist[i] = 0u;
    if (tid < 80) selp[tid] = 0u;
    SEC_T0(12)
    bf16x8 aq[4][2];
    { const bf16_t* qrow = P + (rowbase + t0 + c16) * LDP + PC_QI + g4 * 8;
#pragma unroll
      for (int h = 0; h < 4; ++h)
#pragma unroll
          for (int ks = 0; ks < 2; ++ks) aq[h][ks] = *(const bf16x8*)(qrow + h * 64 + ks * 32); }
    LAS float* wqw = (LAS float*)(lds + SA_FSEL + wave * 256);
    wqw[lane] = bf2f(P[(rowbase + t0 + (lane >> 2)) * LDP + PC_WI + (lane & 3)]) * 0.0625f;
    float sc[33][4]; float mx[4], mn[4];
#pragma unroll
    for (int r = 0; r < 4; ++r) { mx[r] = NINF; mn[r] = __builtin_inff(); }
#pragma unroll
    for (int s = 0; s < 33; ++s) { sc[s][0] = NINF; sc[s][1] = NINF; sc[s][2] = NINF; sc[s][3] = NINF; }
    const int ns = (nkt - wave + 7) >> 3;
    LDSW();
    bf16x8 kb[3][2];
#define S1_LOAD(bi_, s_) do { const int kt_ = wave + 8 * (s_); const int ktc_ = kt_ < nkt ? kt_ : nkt - 1; \
        const bf16_t* kr_ = KI + (rowbase + ktc_ * 16 + c16) * 64 + g4 * 8; kb[bi_][0] = *(const bf16x8*)kr_; kb[bi_][1] = *(const bf16x8*)(kr_ + 32); } while (0)
#define S1_COMP(bi_, s_) do { const int s = (s_); const int kt = wave + 8 * s; f32x4 ac[4]; \
        _Pragma("unroll") for (int h = 0; h < 4; ++h) { ac[h] = __builtin_amdgcn_mfma_f32_16x16x32_bf16(aq[h][0], kb[bi_][0], (f32x4){0.f, 0.f, 0.f, 0.f}, 0, 0, 0); ac[h] = __builtin_amdgcn_mfma_f32_16x16x32_bf16(aq[h][1], kb[bi_][1], ac[h], 0, 0, 0); } \
        _Pragma("unroll") for (int r = 0; r < 4; ++r) { const f32x4 wr_ = *(const LAS f32x4*)(wqw + (4 * g4 + r) * 4); \
            float sv = wr_[0] * fmaxf(ac[0][r], 0.f); \
            sv = __builtin_fmaf(wr_[1], fmaxf(ac[1][r], 0.f), sv); sv = __builtin_fmaf(wr_[2], fmaxf(ac[2][r], 0.f), sv); sv = __builtin_fmaf(wr_[3], fmaxf(ac[3][r], 0.f), sv); \
            sv = (sv == 0.f) ? 0.f : sv;                                                               \
            const bool valid = (kt * 16 + c16 <= t0 + 4 * g4 + r);                                    \
            sc[s][r] = valid ? sv : NINF; mx[r] = fmaxf(mx[r], sc[s][r]); mn[r] = fminf(mn[r], valid ? sv : __builtin_inff()); } } while (0)
#define S1_LVL(k_) if ((k_) < ns) { if ((k_) + 2 < 33) S1_LOAD(((k_) + 2) % 3, (k_) + 2); asm volatile("" ::: "memory");     \
        S1_COMP((k_) % 3, (k_));
    S1_LOAD(0, 0); S1_LOAD(1, 1); asm volatile("" ::: "memory");
    S1_LVL(0) S1_LVL(1) S1_LVL(2) S1_LVL(3) S1_LVL(4) S1_LVL(5) S1_LVL(6) S1_LVL(7) S1_LVL(8) S1_LVL(9) S1_LVL(10) S1_LVL(11) S1_LVL(12) S1_LVL(13) S1_LVL(14) S1_LVL(15) S1_LVL(16) S1_LVL(17) S1_LVL(18) S1_LVL(19) S1_LVL(20) S1_LVL(21) S1_LVL(22) S1_LVL(23) S1_LVL(24) S1_LVL(25) S1_LVL(26) S1_LVL(27) S1_LVL(28) S1_LVL(29) S1_LVL(30) S1_LVL(31) S1_LVL(32)
    } } } } } } } } } } } } } } } } } } } } } } } } } } } } } } } } }
#undef S1_LVL
#undef S1_LOAD
#undef S1_COMP
    SEC_T1(12)
    SEC_T0(13)
    if (!selall) {
#pragma unroll
        for (int r = 0; r < 4; ++r) {
#pragma unroll
            for (int o = 1; o < 16; o <<= 1) { mx[r] = fmaxf(mx[r], __shfl_xor(mx[r], o)); mn[r] = fminf(mn[r], __shfl_xor(mn[r], o)); }
            if (c16 == 0) { smm[(wave * 16 + 4 * g4 + r) * 2] = mx[r]; smm[(wave * 16 + 4 * g4 + r) * 2 + 1] = mn[r]; } }
        __syncthreads();
        if (tid < 16) { float hi = NINF, lo = __builtin_inff();
#pragma unroll
            for (int w8 = 0; w8 < 8; ++w8) { hi = fmaxf(hi, smm[(w8 * 16 + tid) * 2]); lo = fminf(lo, smm[(w8 * 16 + tid) * 2 + 1]); }
            const float scl = hi > lo ? 255.99f / (hi - lo) : 0.f; smm[256 + 2 * tid] = scl; smm[256 + 2 * tid + 1] = -lo * scl; }
        __syncthreads();
        float bsc[4], bof[4];
#pragma unroll
        for (int r = 0; r < 4; ++r) { bsc[r] = smm[256 + 2 * (4 * g4 + r)]; bof[r] = smm[256 + 2 * (4 * g4 + r) + 1]; }
#pragma unroll
        for (int s = 0; s < 33; ++s) if (s < ns) {
#pragma unroll
            for (int r = 0; r < 4; ++r) { unsigned bin = (unsigned)__builtin_fmaf(sc[s][r], bsc[r], bof[r]); bin = bin > 255u ? 255u : bin;
                __hip_atomic_fetch_add(&hist[(4 * g4 + r) * 256 + bin], 1u, __ATOMIC_RELAXED, __HIP_MEMORY_SCOPE_WORKGROUP); } }
        __syncthreads();
#pragma unroll
        for (int qq = 0; qq < 2; ++qq) { const int q = 2 * wave + qq;
            u32x4 cnt = *(const LAS u32x4*)&hist[q * 256 + 252 - 4 * lane];
            if (lane == 63) cnt.x -= (unsigned)(15 - q);
            const unsigned tot = cnt.x + cnt.y + cnt.z + cnt.w;
            const unsigned inc = wave_incl_sum_u(tot, lane), exc = inc - tot;
            if (exc < 256u && 256u <= inc) {
                unsigned cum = exc; int d;
                if (256u <= cum + cnt.w) d = 255 - 4 * lane; else { cum += cnt.w; if (256u <= cum + cnt.z) d = 254 - 4 * lane; else { cum += cnt.z; if (256u <= cum + cnt.y) d = 253 - 4 * lane; else { cum += cnt.y; d = 252 - 4 * lane; } } }
                selp[32 + q] = (unsigned)d; selp[16 + q] = 256u - cum;
            }
        }
        __syncthreads();
        {
            unsigned bst[4];
#pragma unroll
            for (int r = 0; r < 4; ++r) { bst[r] = selp[32 + 4 * g4 + r]; asm volatile("" : "+v"(bsc[r]), "+v"(bof[r])); }
            LAS unsigned* cand = (LAS unsigned*)(lds + SA_CAND);
#pragma unroll
            for (int s = 0; s < 33; ++s) if (s < ns) {
#pragma unroll
                for (int r = 0; r < 4; ++r) { unsigned bin = (unsigned)__builtin_fmaf(sc[s][r], bsc[r], bof[r]); bin = bin > 255u ? 255u : bin;
                    if (bin == bst[r] && sc[s][r] > NINF) { const unsigned pos = __hip_atomic_fetch_add(&selp[48 + 4 * g4 + r], 1u, __ATOMIC_RELAXED, __HIP_MEMORY_SCOPE_WORKGROUP);
                        if (pos < (unsigned)SA_CAP) cand[(4 * g4 + r) * SA_CAP + pos] = f2key(sc[s][r]); } } }
        }
        __syncthreads();
#pragma unroll 1
        for (int qq = 0; qq < 2; ++qq) { const int q = 2 * wave + qq;
            const unsigned m = selp[48 + q], need = selp[16 + q];
            if (m > (unsigned)SA_CAP || FORCE_FALLBACK) { if (lane == 0) selp[64] = 1u; continue; }
            const LAS unsigned* cand = (const LAS unsigned*)(lds + SA_CAND) + q * SA_CAP;
            if (m <= 64u) {
                const unsigned myk = (unsigned)lane < m ? cand[lane] : 0u;
                unsigned cgt = 0u, cge = 0u;
#pragma unroll 1
                for (unsigned j = 0; j < m; ++j) { const unsigned kj = (unsigned)__builtin_amdgcn_readlane((int)myk, (int)j); cgt += (kj > myk) ? 1u : 0u; cge += (kj >= myk) ? 1u : 0u; }
                const unsigned long long hit = __ballot((unsigned)lane < m && cgt < need && need <= cge);
                const int L = (int)__ffsll((long long)hit) - 1;
                const unsigned tk = (unsigned)__builtin_amdgcn_readlane((int)myk, L), tg = (unsigned)__builtin_amdgcn_readlane((int)cgt, L);
                if (lane == 0) { selp[q] = __float_as_uint(key2f(tk)); selp[16 + q] = need - tg; }
                continue;
            }
            unsigned ck[8];
#pragma unroll
            for (int i = 0; i < 8; ++i) ck[i] = (unsigned)(lane + 64 * i) < m ? cand[lane + 64 * i] : 0u;
            const int nreg = (int)((m + 63u) >> 6);
            unsigned trial = 0u;
#pragma unroll 1
            for (int bit = 31; bit >= 0; --bit) { const unsigned t = trial | (1u << bit); unsigned cntv = (unsigned)__popcll(__ballot(ck[0] >= t));
                if (nreg > 1) {
#pragma unroll
                    for (int i = 1; i < 8; ++i) cntv += (unsigned)__popcll(__ballot(ck[i] >= t)); }
                if (cntv >= need) trial = t; }
            unsigned cgt = 0u;
#pragma unroll
            for (int i = 0; i < 8; ++i) cgt += (unsigned)__popcll(__ballot(ck[i] > trial));
            if (lane == 0) { selp[q] = __float_as_uint(key2f(trial)); selp[16 + q] = need - cgt; }
        }
        __syncthreads();
        if (selp[64] != 0u) {
            if (tid < 16) { selp[tid] = 0u; selp[16 + tid] = 256u; }
#pragma unroll 1
            for (int p = 0; p < 4; ++p) {
                const int shift = 24 - 8 * p; const unsigned hmask = (p == 0) ? 0u : (0xFFFFFFFFu << (shift + 8));
                __syncthreads();
                for (int i = tid; i < 4096; i += 512) hist[i] = 0u;
                __syncthreads();
                unsigned pf[4]; unsigned zero = 0u; asm volatile("" : "+v"(zero));
#pragma unroll
                for (int r = 0; r < 4; ++r) pf[r] = selp[4 * g4 + r];
#pragma unroll
                for (int s = 0; s < 33; ++s)
#pragma unroll
                    for (int r = 0; r < 4; ++r) { const unsigned key = f2key(__uint_as_float(__float_as_uint(sc[s][r]) | zero));
                        if (sc[s][r] > NINF && ((key ^ pf[r]) & hmask) == 0u) __hip_atomic_fetch_add(&hist[(4 * g4 + r) * 256 + ((key >> shift) & 255u)], 1u, __ATOMIC_RELAXED, __HIP_MEMORY_SCOPE_WORKGROUP); }
                __syncthreads();
#pragma unroll
                for (int qq = 0; qq < 2; ++qq) { const int q = 2 * wave + qq;
                    const u32x4 cnt = *(const LAS u32x4*)&hist[q * 256 + 252 - 4 * lane];
                    const unsigned tot = cnt.x + cnt.y + cnt.z + cnt.w;
                    const unsigned inc = wave_incl_sum_u(tot, lane), exc = inc - tot;
                    const unsigned krem = selp[16 + q];
                    if (exc < krem && krem <= inc) {
                        unsigned cum = exc; int d;
                        if (krem <= cum + cnt.w) d = 255 - 4 * lane; else { cum += cnt.w; if (krem <= cum + cnt.z) d = 254 - 4 * lane; else { cum += cnt.z; if (krem <= cum + cnt.y) d = 253 - 4 * lane; else { cum += cnt.y; d = 252 - 4 * lane; } } }
                        selp[q] = selp[q] | ((unsigned)d << shift); selp[16 + q] = krem - cum;
                    }
                }
            }
            __syncthreads();
            if (tid < 16) selp[tid] = __float_as_uint(key2f(selp[tid]));
            __syncthreads();
        }
    } else __syncthreads();
    SEC_T1(13)
    SEC_T0(14)
    {
        int nkt3 = nkt; asm volatile("" : "+s"(nkt3));
        float tau[4];
#pragma unroll
        for (int r = 0; r < 4; ++r) tau[r] = selall ? NINF : __uint_as_float(selp[4 * g4 + r]);
        LAS unsigned long long* bg64 = (LAS unsigned long long*)(lds + SA_GT); LAS unsigned long long* be64 = (LAS unsigned long long*)(lds + SA_EQ);
#pragma unroll
        for (int s = 0; s < 33; ++s) {
            const int kt = wave + 8 * s;
            if (kt < nkt3) {
#pragma unroll
                for (int r = 0; r < 4; ++r) { const float x = sc[s][r]; const bool g = x > tau[r]; const bool e = (!selall) && (x == tau[r]);
                    const unsigned long long vg = __ballot(g), ve = __ballot(e);
                    if (lane == 0) { bg64[kt * 4 + r] = vg; be64[kt * 4 + r] = ve; } }
            }
            __builtin_amdgcn_sched_barrier(0);
        }
    }
    __syncthreads();
    SEC_T1(14)
    SEC_T0(15)
    if (qb < DENSE_QB) {
    SEC_T0(23)
    LAS unsigned* fsel = (LAS unsigned*)(lds + SA_FSEL);
#pragma unroll
    for (int qq = 0; qq < 2; ++qq) {
        const int q = 2 * wave + qq;
        const LAS unsigned short* hgt = (const LAS unsigned short*)(lds + SA_GT) + (q & 3) * 4 + (q >> 2); const LAS unsigned short* heq = (const LAS unsigned short*)(lds + SA_EQ) + (q & 3) * 4 + (q >> 2);
#define SA_WORD(hp, j) ((unsigned)(hp)[(2 * (j)) * 16] | ((unsigned)(hp)[(2 * (j) + 1) * 16] << 16))
        unsigned g0 = SA_WORD(hgt, lane), g1 = SA_WORD(hgt, lane + 64), g2 = lane < 4 ? SA_WORD(hgt, lane + 128) : 0u;
        unsigned e0 = SA_WORD(heq, lane), e1 = SA_WORD(heq, lane + 64), e2 = lane < 4 ? SA_WORD(heq, lane + 128) : 0u;
#undef SA_WORD
        const unsigned krem = selall ? 0u : selp[16 + q];
        {
            const unsigned c0 = __popc(e0), c1 = __popc(e1), c2 = __popc(e2);
            const unsigned i0 = wave_incl_sum_u(c0, lane), i1 = wave_incl_sum_u(c1, lane), i2 = wave_incl_sum_u(c2, lane);
            const unsigned T0 = __shfl(i0, 63), T1 = __shfl(i1, 63);
            const unsigned x0 = i0 - c0, x1 = T0 + i1 - c1, x2 = T0 + T1 + i2 - c2;
            e0 = keep_low(e0, krem > x0 ? krem - x0 : 0u); e1 = keep_low(e1, krem > x1 ? krem - x1 : 0u); e2 = keep_low(e2, krem > x2 ? krem - x2 : 0u);
        }
        fsel[q * 132 + lane] = g0 | e0; fsel[q * 132 + lane + 64] = g1 | e1; if (lane < 4) fsel[q * 132 + lane + 128] = g2 | e2;
    }
    LDSW();
    {
        const int g = wave & 1, qquad = wave >> 1, qi = 4 * qquad + (c16 >> 2), hq = 4 * g + (c16 & 3);
        const int nsteps = (t0 + 16 + 63) >> 6;
        const char* kvb = (const char*)(KV + rowbase * 256);
        LAS unsigned char* tile0 = lds + SA_SP; LAS unsigned char* tile1 = lds + SA_SP + 64 * 528;
        const int srow = tid >> 5, schk = tid & 31;
        u32x4 pre[4];
#define DA_LOAD(st_) do { _Pragma("unroll") for (int k2 = 0; k2 < 4; ++k2) { int key_ = 64 * (st_) + srow + 16 * k2; key_ = key_ < T ? key_ : T - 1; pre[k2] = *(const u32x4*)(kvb + (size_t)key_ * 512 + schk * 16); } } while (0)
#define DA_STORE(tl_) do { _Pragma("unroll") for (int k2 = 0; k2 < 4; ++k2) *(LAS u32x4*)((tl_) + (srow + 16 * k2) * 528 + schk * 16) = pre[k2]; } while (0)
        bf16x8 qf[2];
#pragma unroll
        for (int ks = 0; ks < 2; ++ks) qf[ks] = *(const bf16x8*)(P + (rowbase + t0 + qi) * LDP + PC_Q + hq * 64 + 8 * g4 + 32 * ks);
        DA_LOAD(0); DA_STORE(tile0);
        if (nsteps > 1) DA_LOAD(1);
        f32x4 oacc[4];
#pragma unroll
        for (int dt = 0; dt < 4; ++dt) oacc[dt] = (f32x4){0.f, 0.f, 0.f, 0.f};
        float mrun = 0.f, lrun = 0.f; bool seen = false;
        LDSW();
        __syncthreads();
#pragma unroll 1
        for (int st = 0; st < nsteps; ++st) {
            LAS unsigned char* cur = (st & 1) ? tile1 : tile0; LAS unsigned char* nxt = (st & 1) ? tile0 : tile1;
            if (st + 1 < nsteps) DA_STORE(nxt);
            if (st + 2 < nsteps) DA_LOAD(st + 2);
            f32x4 sc2[4];
#pragma unroll
            for (int sub = 0; sub < 4; ++sub) { f32x4 ac = (f32x4){0.f, 0.f, 0.f, 0.f};
#pragma unroll
                for (int ks = 0; ks < 2; ++ks) ac = __builtin_amdgcn_mfma_f32_16x16x32_bf16(*(const LAS bf16x8*)(cur + (16 * sub + c16) * 528 + g * 128 + (8 * g4 + 32 * ks) * 2), qf[ks], ac, 0, 0, 0);
                sc2[sub] = ac; }
            const u32x2 mw2 = *(const LAS u32x2*)&fsel[qi * 132 + 2 * st];
            const unsigned mwa = mw2.x >> (4 * g4), mwb = mw2.y >> (4 * g4);
            float lmax = -3.0e38f;
#pragma unroll
            for (int sub = 0; sub < 4; ++sub)
#pragma unroll
                for (int r = 0; r < 4; ++r) { const int sel = ((int)(((sub < 2) ? mwa : mwb) << (31 - (16 * (sub & 1) + r)))) >> 31;
                    const unsigned tb = __float_as_uint(__builtin_fmaf(sc2[sub][r], 0.18033688011112042f, -mrun));
                    const float t = __uint_as_float((tb & (unsigned)sel) | (0xff7fffffu & ~(unsigned)sel));
                    sc2[sub][r] = t; lmax = fmaxf(lmax, t); }
            if (__any(lmax > 11.5f || (!seen && lmax > -1e37f))) {
                float tm = fmaxf(lmax, __shfl_xor(lmax, 16)); tm = fmaxf(tm, __shfl_xor(tm, 32));
                const bool any_key = tm > -1e37f;
                const float dl = seen ? fmaxf(tm, 0.f) : (any_key ? tm : 0.f);
                seen = seen || any_key;
                const float alpha = __builtin_amdgcn_exp2f(-dl);
                lrun *= alpha; mrun += dl;
#pragma unroll
                for (int sub = 0; sub < 4; ++sub)
#pragma unroll
                    for (int r = 0; r < 4; ++r) sc2[sub][r] -= dl;
#pragma unroll
                for (int r = 0; r < 4; ++r) { const float ar = __shfl(alpha, 4 * g4 + r);
#pragma unroll
                    for (int dt = 0; dt < 4; ++dt) oacc[dt][r] *= ar; }
            }
            float pv[4][4];
#pragma unroll
            for (int sub = 0; sub < 4; ++sub)
#pragma unroll
                for (int r = 0; r < 4; ++r) { const float p = __builtin_amdgcn_exp2f(sc2[sub][r]); pv[sub][r] = p; lrun += p; }
            bf16x8 pa[2];
#pragma unroll
            for (int h2 = 0; h2 < 2; ++h2) { u32x4 pw; pw.x = cvt_pk_bf16(pv[2 * h2][0], pv[2 * h2][1]); pw.y = cvt_pk_bf16(pv[2 * h2][2], pv[2 * h2][3]); pw.z = cvt_pk_bf16(pv[2 * h2 + 1][0], pv[2 * h2 + 1][1]); pw.w = cvt_pk_bf16(pv[2 * h2 + 1][2], pv[2 * h2 + 1][3]); pa[h2] = __builtin_bit_cast(bf16x8, pw); }
#pragma unroll
            for (int dt = 0; dt < 4; ++dt)
#pragma unroll
                for (int h2 = 0; h2 < 2; ++h2) {
                    const LAS unsigned char* p0 = cur + (32 * h2 + 4 * g4 + (c16 >> 2)) * 528 + (128 + 64 * g + 16 * dt + 4 * (c16 & 3)) * 2;
                    const s16x4 a = __builtin_bit_cast(s16x4, __builtin_amdgcn_ds_read_tr16_b64_v4i16((LAS s16x4*)p0)), b = __builtin_bit_cast(s16x4, __builtin_amdgcn_ds_read_tr16_b64_v4i16((LAS s16x4*)(p0 + 16 * 528)));
                    oacc[dt] = __builtin_amdgcn_mfma_f32_16x16x32_bf16(pa[h2], (bf16x8){a[0], a[1], a[2], a[3], b[0], b[1], b[2], b[3]}, oacc[dt], 0, 0, 0);
                }
            LDSW();
            __syncthreads();
        }
#undef DA_LOAD
#undef DA_STORE
        float lt = lrun + __shfl_xor(lrun, 16); lt += __shfl_xor(lt, 32);
        const float invl = 1.0f / lt;
        bf16_t* orow = YB + (rowbase + t0 + 4 * qquad + g4) * LDY + 512 + (4 * g) * 64 + c16;
#pragma unroll
        for (int r = 0; r < 4; ++r) { const float ir = __shfl(invl, 4 * g4 + r);
#pragma unroll
            for (int dt = 0; dt < 4; ++dt) orow[r * 64 + 16 * dt] = (bf16_t)(cvt_pk_bf16(oacc[dt][r] * ir, 0.f) & 0xffffu); }
    }
    SEC_T1(23)
    } else {
    SEC_T0(24)
    LAS unsigned* lists = (LAS unsigned*)(lds + SA_LISTS + wave * 2048);
    int nsel2[2];
#pragma unroll
    for (int qq = 0; qq < 2; ++qq) {
        const int q = 2 * wave + qq;
        const LAS unsigned short* hgt = (const LAS unsigned short*)(lds + SA_GT) + (q & 3) * 4 + (q >> 2); const LAS unsigned short* heq = (const LAS unsigned short*)(lds + SA_EQ) + (q & 3) * 4 + (q >> 2);
#define SA_WORD(hp, j) ((unsigned)(hp)[(2 * (j)) * 16] | ((unsigned)(hp)[(2 * (j) + 1) * 16] << 16))
        unsigned g0 = SA_WORD(hgt, lane), g1 = SA_WORD(hgt, lane + 64), g2 = lane < 4 ? SA_WORD(hgt, lane + 128) : 0u;
        unsigned e0 = SA_WORD(heq, lane), e1 = SA_WORD(heq, lane + 64), e2 = lane < 4 ? SA_WORD(heq, lane + 128) : 0u;
#undef SA_WORD
        const unsigned krem = selall ? 0u : selp[16 + q];
        {
            const unsigned c0 = __popc(e0), c1 = __popc(e1), c2 = __popc(e2);
            const unsigned i0 = wave_incl_sum_u(c0, lane), i1 = wave_incl_sum_u(c1, lane), i2 = wave_incl_sum_u(c2, lane);
            const unsigned T0 = __shfl(i0, 63), T1 = __shfl(i1, 63);
            const unsigned x0 = i0 - c0, x1 = T0 + i1 - c1, x2 = T0 + T1 + i2 - c2;
            e0 = keep_low(e0, krem > x0 ? krem - x0 : 0u); e1 = keep_low(e1, krem > x1 ? krem - x1 : 0u); e2 = keep_low(e2, krem > x2 ? krem - x2 : 0u);
        }
        g0 |= e0; g1 |= e1; g2 |= e2;
        {
            LAS unsigned* list = lists + qq * 256;
            const unsigned c0 = __popc(g0), c1 = __popc(g1), c2 = __popc(g2);
            const unsigned i0 = wave_incl_sum_u(c0, lane), i1 = wave_incl_sum_u(c1, lane), i2 = wave_incl_sum_u(c2, lane);
            const unsigned T0 = __shfl(i0, 63), T1 = __shfl(i1, 63), T2 = __shfl(i2, 63);
            unsigned o0 = i0 - c0, o1 = T0 + i1 - c1, o2 = T0 + T1 + i2 - c2;
            int nsel = (int)(T0 + T1 + T2); nsel2[qq] = nsel > 256 ? 256 : nsel;
            while (g0) { const int b = __ffs(g0) - 1; if (o0 < 256u) list[o0] = (unsigned)(32 * lane + b) * 512u; ++o0; g0 &= g0 - 1u; }
            while (g1) { const int b = __ffs(g1) - 1; if (o1 < 256u) list[o1] = (unsigned)(32 * (lane + 64) + b) * 512u; ++o1; g1 &= g1 - 1u; }
            while (g2) { const int b = __ffs(g2) - 1; if (o2 < 256u) list[o2] = (unsigned)(32 * (lane + 128) + b) * 512u; ++o2; g2 &= g2 - 1u; }
#pragma unroll
            for (int i = 0; i < 4; ++i) if (lane + 64 * i >= nsel2[qq]) list[lane + 64 * i] = 0u;
        }
    }
    LDSW();
    __syncthreads();
    SEC_T1(24)
    LAS float* sP = (LAS float*)(lds + SA_SPS + wave * 8192);
    LAS unsigned char* vst = lds + wave * 4608;
#define SA_KLOAD(dst, kg0_) do { _Pragma("unroll") for (int u = 0; u < 4; ++u) { const unsigned off_ = list[16 * ((kg0_) + u) + c16] + 16u * (unsigned)g4; \
        const bf16_t* kvrow_ = (const bf16_t*)(kvb + off_); \
        _Pragma("unroll") for (int g = 0; g < 2; ++g) { dst[u][g][0] = *(const bf16x8*)(kvrow_ + g * 64); dst[u][g][1] = *(const bf16x8*)(kvrow_ + g * 64 + 32); } } } while (0)
#define SA_KCOMP(src, kg0_) do { _Pragma("unroll") for (int u = 0; u < 4; ++u) { const int kk_ = 16 * ((kg0_) + u) + c16; \
        _Pragma("unroll") for (int g = 0; g < 2; ++g) { \
            f32x4 ac_ = __builtin_amdgcn_mfma_f32_16x16x32_bf16(qa[g][0], src[u][g][0], (f32x4){0.f, 0.f, 0.f, 0.f}, 0, 0, 0); \
            ac_ = __builtin_amdgcn_mfma_f32_16x16x32_bf16(qa[g][1], src[u][g][1], ac_, 0, 0, 0); \
            if (g4 == 0) *(LAS f32x4*)&sP[kk_ * 8 + 4 * g] = ac_ * 0.125f; } } } while (0)
#define SA_VLOAD(dst, hf_, g_, kh_) do { _Pragma("unroll") for (int k2 = 0; k2 < 2; ++k2) _Pragma("unroll") for (int i = 0; i < 4; ++i) { const unsigned off_ = list[128 * (hf_) + 32 * (2 * (kh_) + k2) + 8 * i + (lane >> 3)] + 16u * (unsigned)(lane & 7); \
        dst[k2][i] = *(const u32x4*)(kvb + off_ + 256 + (g_) * 128); } } while (0)
#define SA_VCOMP(src, hf_, g_, kh_) do { _Pragma("unroll") for (int k2 = 0; k2 < 2; ++k2) { \
        _Pragma("unroll") for (int i = 0; i < 4; ++i) *(LAS u32x4*)(vst + (8 * i + (lane >> 3)) * 144 + (lane & 7) * 16) = src[k2][i]; \
        const bf16x8 pa_ = *(const LAS bf16x8*)((const LAS unsigned char*)sP + (4 * (g_) + (c16 & 3)) * 528 + (128 * (hf_) + 32 * (2 * (kh_) + k2) + 8 * g4) * 2); \
        _Pragma("unroll") for (int dt = 0; dt < 4; ++dt) { const LAS unsigned char* p0_ = vst + (8 * g4 + (c16 >> 2)) * 144 + (16 * dt + 4 * (c16 & 3)) * 2; \
            const s16x4 a_ = __builtin_bit_cast(s16x4, __builtin_amdgcn_ds_read_tr16_b64_v4i16((LAS s16x4*)p0_)), b_ = __builtin_bit_cast(s16x4, __builtin_amdgcn_ds_read_tr16_b64_v4i16((LAS s16x4*)(p0_ + 4 * 144))); \
            oacc[g_][dt] = __builtin_amdgcn_mfma_f32_16x16x32_bf16(pa_, (bf16x8){a_[0], a_[1], a_[2], a_[3], b_[0], b_[1], b_[2], b_[3]}, oacc[g_][dt], 0, 0, 0); } } } while (0)
#define SA_VOK(hf_, kh_) (128 * (hf_) + 64 * (kh_) < nsel)
#define SA_RED8(v, OP) do { \
        { const bool up_ = lane >= 32; _Pragma("unroll") for (int h = 0; h < 4; ++h) { const float mine_ = up_ ? v[4 + h] : v[h], send_ = up_ ? v[h] : v[4 + h]; v[h] = OP(mine_, __shfl_xor(send_, 32)); } } \
        { const bool up_ = (lane & 16) != 0; _Pragma("unroll") for (int h = 0; h < 2; ++h) { const float mine_ = up_ ? v[2 + h] : v[h], send_ = up_ ? v[h] : v[2 + h]; v[h] = OP(mine_, __shfl_xor(send_, 16)); } } \
        { const bool up_ = (lane & 8) != 0; const float mine_ = up_ ? v[1] : v[0], send_ = up_ ? v[0] : v[1]; v[0] = OP(mine_, __shfl_xor(send_, 8)); } \
        v[0] = OP(v[0], __shfl_xor(v[0], 1)); v[0] = OP(v[0], __shfl_xor(v[0], 2)); v[0] = OP(v[0], __shfl_xor(v[0], 4)); \
        { const float r_ = v[0]; _Pragma("unroll") for (int h = 0; h < 8; ++h) v[h] = __int_as_float(__builtin_amdgcn_readlane(__float_as_int(r_), 8 * h)); } } while (0)
#define SA_FMAX(a_, b_) fmaxf(a_, b_)
#define SA_FADD(a_, b_) ((a_) + (b_))
#pragma unroll 1
    for (int qq = 0; qq < 2; ++qq) {
        const int tq = t0 + 2 * wave + qq; const int nsel = qq ? nsel2[1] : nsel2[0];
        const LAS unsigned* list = lists + qq * 256;
        const char* kvb = (const char*)(KV + rowbase * 256);
        bf16x8 qa[2][2];
#pragma unroll
        for (int g = 0; g < 2; ++g)
#pragma unroll
            for (int ks = 0; ks < 2; ++ks) qa[g][ks] = *(const bf16x8*)(P + (rowbase + tq) * LDP + PC_Q + (4 * g + (c16 & 3)) * 64 + 8 * g4 + 32 * ks);
        const int ngrp = (nsel + 15) >> 4;
        u32x4 vrA[2][4], vrB[2][4];
        bf16x8 kbA[4][2][2], kbB[4][2][2];
        SA_KLOAD(kbA, 0);
        SEC_T0(21)
        if (ngrp > 4) SA_KLOAD(kbB, 4);
        SA_KCOMP(kbA, 0);
        if (ngrp > 4) {
            if (ngrp > 8) SA_KLOAD(kbA, 8);
            SA_KCOMP(kbB, 4);
            if (ngrp > 8) {
                if (ngrp > 12) SA_KLOAD(kbB, 12);
                SA_KCOMP(kbA, 8);
                if (ngrp > 12) SA_KCOMP(kbB, 12);
            }
        }
        SEC_T1(21)
        SEC_T0(25)
        SA_VLOAD(vrA, 0, 0, 0);
        LDSW();
        float inv[8];
        {
            f32x4 sa_[4][2]; float mx[8];
#pragma unroll
            for (int h = 0; h < 8; ++h) mx[h] = NINF;
#pragma unroll
            for (int i = 0; i < 4; ++i) { const int kk = lane + 64 * i;
                if (kk < nsel) { sa_[i][0] = *(const LAS f32x4*)&sP[kk * 8]; sa_[i][1] = *(const LAS f32x4*)&sP[kk * 8 + 4]; }
                else { sa_[i][0] = (f32x4){NINF, NINF, NINF, NINF}; sa_[i][1] = sa_[i][0]; }
#pragma unroll
                for (int h = 0; h < 8; ++h) mx[h] = fmaxf(mx[h], sa_[i][h >> 2][h & 3]); }
            LDSW();
            SA_RED8(mx, SA_FMAX);
            float sm[8];
#pragma unroll
            for (int h = 0; h < 8; ++h) sm[h] = 0.f;
#pragma unroll
            for (int i = 0; i < 4; ++i) { const int kk = lane + 64 * i;
#pragma unroll
                for (int h = 0; h < 8; ++h) { const float pv = (kk < nsel) ? fast_exp(sa_[i][h >> 2][h & 3] - mx[h]) : 0.f; sm[h] += pv;
                    *(LAS unsigned short*)((LAS unsigned char*)sP + h * 528 + kk * 2) = (unsigned short)(cvt_pk_bf16(pv, 0.f) & 0xffffu); } }
            SA_RED8(sm, SA_FADD);
#pragma unroll
            for (int h = 0; h < 8; ++h) inv[h] = 1.0f / sm[h];
        }
        LDSW();
        SEC_T1(25)
        SEC_T0(22)
        f32x4 oacc[2][4];
#pragma unroll
        for (int g = 0; g < 2; ++g)
#pragma unroll
            for (int dt = 0; dt < 4; ++dt) oacc[g][dt] = (f32x4){0.f, 0.f, 0.f, 0.f};
        if (SA_VOK(0, 1)) SA_VLOAD(vrB, 0, 0, 1);
        SA_VCOMP(vrA, 0, 0, 0);
        SA_VLOAD(vrA, 0, 1, 0);
        if (SA_VOK(0, 1)) SA_VCOMP(vrB, 0, 0, 1);
        if (SA_VOK(0, 1)) SA_VLOAD(vrB, 0, 1, 1);
        SA_VCOMP(vrA, 0, 1, 0);
        if (SA_VOK(1, 0)) SA_VLOAD(vrA, 1, 0, 0);
        if (SA_VOK(0, 1)) SA_VCOMP(vrB, 0, 1, 1);
        if (SA_VOK(1, 0)) {
            if (SA_VOK(1, 1)) SA_VLOAD(vrB, 1, 0, 1);
            SA_VCOMP(vrA, 1, 0, 0);
            SA_VLOAD(vrA, 1, 1, 0);
            if (SA_VOK(1, 1)) SA_VCOMP(vrB, 1, 0, 1);
            if (SA_VOK(1, 1)) SA_VLOAD(vrB, 1, 1, 1);
        }
        if (SA_VOK(1, 0)) {
            SA_VCOMP(vrA, 1, 1, 0);
            if (SA_VOK(1, 1)) SA_VCOMP(vrB, 1, 1, 1);
        }
        SEC_T1(22)
        SEC_T0(26)
        if (g4 == 0) {
            bf16_t* orow = YB + (rowbase + tq) * LDY + 512 + c16;
#pragma unroll
            for (int g = 0; g < 2; ++g)
#pragma unroll
                for (int dt = 0; dt < 4; ++dt)
#pragma unroll
                    for (int r = 0; r < 4; ++r) orow[(4 * g + r) * 64 + 16 * dt] = (bf16_t)(cvt_pk_bf16(oacc[g][dt][r] * inv[4 * g + r], 0.f) & 0xffffu);
        }
        LDSW();
        SEC_T1(26)
    }
#undef SA_KLOAD
#undef SA_KCOMP
#undef SA_VLOAD
#undef SA_VCOMP
#undef SA_VOK
#undef SA_RED8
#undef SA_FMAX
#undef SA_FADD
    }
    SEC_T1(15)
}

constexpr int QS = 272, WS_ = 144;
constexpr int MLA_KW = 0, MLA_V = 64 * QS, MLA_SCR = 2 * 64 * QS;
constexpr int MLC_Q = 0, MLC_K = 64 * QS, MLC_V = 2 * 64 * QS, MLC_MO = 3 * 64 * QS, MLC_W = 4 * 64 * QS  , MLC_SCR = MLC_W + 64 * WS_  , MLC_SS = MLC_SCR + 8 * 1024, MLC_N = MLC_SS + 2048, MLC_QN = MLC_N + 512, MLC_R = MLC_QN + 256;
constexpr size_t CB_CHUNK = 128 * 128;
__device__ __forceinline__ bf16x8 tr_frag(const LAS unsigned char* img, int r0, int r1, int col0, int c16) {
    const LAS unsigned char* p0 = img + (r0 + (c16 >> 2)) * QS + (col0 + 4 * (c16 & 3)) * 2; const LAS unsigned char* p1 = img + (r1 + (c16 >> 2)) * QS + (col0 + 4 * (c16 & 3)) * 2;
    const s16x4 a = __builtin_bit_cast(s16x4, __builtin_amdgcn_ds_read_tr16_b64_v4i16((LAS s16x4*)p0)), b = __builtin_bit_cast(s16x4, __builtin_amdgcn_ds_read_tr16_b64_v4i16((LAS s16x4*)p1));
    return (bf16x8){a[0], a[1], a[2], a[3], b[0], b[1], b[2], b[3]};
}
__device__ __forceinline__ bf16x8 mk_frag(u32x2 lo, u32x2 hi) { u32x4 w; w.x = lo.x; w.y = lo.y; w.z = hi.x; w.w = hi.y; return __builtin_bit_cast(bf16x8, w); }
__device__ __forceinline__ void ml_gates(const bf16_t* P, size_t rowbase, int c, int hd, float bi, float bfg, int lane, float& logi, float& lf) {
    const int tt = 64 * c - 48 + lane; logi = -__builtin_inff(); lf = 0.f;
    if (tt >= 0) { const bf16_t* gp = P + (rowbase + tt) * LDP; logi = bf2f(gp[PC_MI + hd]) + bi; const float f = bf2f(gp[PC_MF + hd]) + bfg; lf = fminf(f, 0.f) - __builtin_amdgcn_logf(1.0f + fast_exp(-fabsf(f))) * 0.69314718056f; }
}

__device__ __forceinline__ void mlA_item(LAS unsigned char* lds, const bf16_t* P, const float* b_i, const float* b_f, bf16_t* CB, float* NB, float* SC, int bl, int hd, int c, int tid, int lane, int wave) {
    asm volatile("" : "+v"(tid)); lane = tid & 63;
    const size_t rowbase = (size_t)bl * T; const int c16 = lane & 15, g4 = lane >> 4;
    const size_t slot = (size_t)(bl * 4 + hd) * 65 + c;
    const int sl = tid >> 4, scc = tid & 15;
    u32x4 pk[2], pv[2];
#pragma unroll
    for (int k2 = 0; k2 < 2; ++k2) { const int tt = 64 * c - 48 + sl + 32 * k2;
        if (tt >= 0) { const bf16_t* rp = P + (rowbase + tt) * LDP + PC_MK + hd * 128 + 8 * scc; pk[k2] = __builtin_nontemporal_load((const u32x4*)rp); pv[k2] = __builtin_nontemporal_load((const u32x4*)(rp + 512)); }
        else { pk[k2] = (u32x4){0u, 0u, 0u, 0u}; pv[k2] = pk[k2]; } }
    float logi, lf; ml_gates(P, rowbase, c, hd, b_i[hd], b_f[hd], lane, logi, lf);
    const float b = wave_incl_sum(lf, lane), av = logi - b, A63 = wave_max(av), bL = __shfl(b, 63);
    LAS float* sW = (LAS float*)(lds + MLA_SCR + wave * 256);
    sW[lane] = fast_exp(av - A63) * 0.08838834764831845f;
    LDSW();
#pragma unroll
    for (int k2 = 0; k2 < 2; ++k2) { const int l = sl + 32 * k2; const int o = l * QS + scc * 16; const float wk = sW[l]; u32x4 kw;
#pragma unroll
        for (int j = 0; j < 4; ++j) kw[j] = cvt_pk_bf16(bf_lo(pk[k2][j]) * wk, bf_hi(pk[k2][j]) * wk);
        *(LAS u32x4*)(lds + MLA_KW + o) = kw; *(LAS u32x4*)(lds + MLA_V + o) = pv[k2]; }
    LDSW();
    __syncthreads();
    bf16x8 vf[2];
#pragma unroll
    for (int ks = 0; ks < 2; ++ks) vf[ks] = tr_frag(lds + MLA_V, 32 * ks + 8 * g4, 32 * ks + 8 * g4 + 4, 16 * wave, c16);
    f32x4 acc[8];
#pragma unroll
    for (int dt = 0; dt < 8; ++dt) { f32x4 cc = (f32x4){0.f, 0.f, 0.f, 0.f};
#pragma unroll
        for (int ks = 0; ks < 2; ++ks) cc = __builtin_amdgcn_mfma_f32_16x16x32_bf16(tr_frag(lds + MLA_KW, 32 * ks + 8 * g4, 32 * ks + 8 * g4 + 4, 16 * dt, c16), vf[ks], cc, 0, 0, 0);
        acc[dt] = cc; }
    u32x4* cb = (u32x4*)(CB + slot * CB_CHUNK) + (wave * 4) * 64 + lane;
#pragma unroll
    for (int kd = 0; kd < 4; ++kd) __builtin_nontemporal_store(pg8::pack8(acc[2 * kd], acc[2 * kd + 1]), cb + kd * 64);
    if (tid < 64) { float s0 = 0.f, s1 = 0.f;
#pragma unroll 16
        for (int sr = 0; sr < 64; ++sr) { const unsigned w = *(const LAS unsigned*)(lds + MLA_KW + sr * QS + tid * 4); s0 += bf_lo(w); s1 += bf_hi(w); }
        *(f32x2*)(NB + slot * 128 + 2 * tid) = (f32x2){s0, s1};
        if (tid == 0) { SC[slot * 2] = bL; SC[slot * 2 + 1] = A63; } }
}

__device__ __forceinline__ void mlB_scan(bf16_t* CB, float* NB, const float* SC, float* MB, int blk, int nthreads, int wave_id) {
    int tid_ = wave_id * 64 + fresh_lane(); asm volatile("" : "+v"(tid_)); const int gtid = blk * 512 + tid_;
    for (int wi = gtid; wi < 32 * 4096; wi += nthreads) {
        const int chain = wi >> 12, e4 = wi & 4095;
        u32x2* cp = (u32x2*)(CB + (size_t)chain * 65 * CB_CHUNK) + e4;
        const f32x2* sc = (const f32x2*)(SC + (size_t)chain * 65 * 2);
        f32x4 st = (f32x4){0.f, 0.f, 0.f, 0.f}; float m = 0.f;
#pragma unroll 1
        for (int c0 = 0; c0 < 65; c0 += 13) {
            u32x2 d[13]; f32x2 s2[13];
#pragma unroll
            for (int i = 0; i < 13; ++i) { d[i] = cp[(size_t)(c0 + i) * (CB_CHUNK / 4)]; s2[i] = sc[c0 + i]; }
#pragma unroll
            for (int i = 0; i < 13; ++i) {
                const float bL = s2[i].x, A63 = s2[i].y;
                const float Mx = fmaxf(m, A63), dec = fast_exp(m - Mx), sca = fast_exp(A63 - Mx);
                u32x2 o; o.x = cvt_pk_bf16(st[0], st[1]); o.y = cvt_pk_bf16(st[2], st[3]); cp[(size_t)(c0 + i) * (CB_CHUNK / 4)] = o;
                st = st * dec + (f32x4){bf_lo(d[i].x), bf_hi(d[i].x), bf_lo(d[i].y), bf_hi(d[i].y)} * sca;
                m = bL + Mx;
            }
        }
    }
    for (int wi = gtid; wi < 32 * 32; wi += nthreads) {
        const int chain = wi >> 5, e4 = wi & 31;
        f32x4* np = (f32x4*)(NB + (size_t)chain * 65 * 128) + e4;
        const f32x2* sc = (const f32x2*)(SC + (size_t)chain * 65 * 2);
        f32x4 nst = (f32x4){0.f, 0.f, 0.f, 0.f}; float m = 0.f;
#pragma unroll 1
        for (int c0 = 0; c0 < 65; c0 += 13) {
            f32x4 d[13]; f32x2 s2[13];
#pragma unroll
            for (int i = 0; i < 13; ++i) { d[i] = np[(c0 + i) * 32]; s2[i] = sc[c0 + i]; }
#pragma unroll
            for (int i = 0; i < 13; ++i) {
                const float bL = s2[i].x, A63 = s2[i].y;
                const float Mx = fmaxf(m, A63), dec = fast_exp(m - Mx), sca = fast_exp(A63 - Mx);
                np[(c0 + i) * 32] = nst; nst = nst * dec + d[i] * sca;
                if (e4 == 0) MB[chain * 65 + c0 + i] = m;
                m = bL + Mx;
            }
        }
    }
}

__device__ __forceinline__ void mlC_item(LAS unsigned char* lds, const bf16_t* P, bf16_t* YB, const float* b_i, const float* b_f, const float* mh_g, const bf16_t* CB, const float* NB, const float* MB, int bl, int hd, int c, int tid, int lane, int wave) {
    asm volatile("" : "+v"(tid)); lane = tid & 63;
    const size_t rowbase = (size_t)bl * T; const int c16 = lane & 15, g4 = lane >> 4;
    const size_t slot = (size_t)(bl * 4 + hd) * 65 + c;
    LAS float* scr = (LAS float*)(lds + MLC_SCR + wave * 1024);
    LAS float* sA = scr, *sM = scr + 64, *sI = scr + 128, *sE = scr + 192;
    LAS float* sss = (LAS float*)(lds + MLC_SS); LAS float* sn = (LAS float*)(lds + MLC_N); LAS float* sqn = (LAS float*)(lds + MLC_QN); LAS float* sR = (LAS float*)(lds + MLC_R);
    const int sl = tid >> 4, scc = tid & 15;
    u32x4 pq[2], pk[2], pv[2], po[2];
#pragma unroll
    for (int k2 = 0; k2 < 2; ++k2) { const int tt = 64 * c - 48 + sl + 32 * k2;
        if (tt >= 0) { const bf16_t* rp = P + (rowbase + tt) * LDP + PC_MQ + hd * 128 + 8 * scc; pq[k2] = *(const u32x4*)rp; pk[k2] = *(const u32x4*)(rp + 512); pv[k2] = *(const u32x4*)(rp + 1024); po[k2] = *(const u32x4*)(rp + 1536); }
        else { pq[k2] = (u32x4){0u, 0u, 0u, 0u}; pk[k2] = pq[k2]; pv[k2] = pq[k2]; po[k2] = pq[k2]; } }
    u32x4 cfr[4];
    { const u32x4* cb = (const u32x4*)(CB + slot * CB_CHUNK) + (wave * 4) * 64 + lane;
#pragma unroll
      for (int kd = 0; kd < 4; ++kd) cfr[kd] = cb[kd * 64]; }
    const float mprev = MB[slot];
    if (tid < 128) sn[tid] = NB[slot * 128 + tid];
    const float gmh = mh_g[hd * 128 + 16 * wave + c16];
    {
        float logi, lf; ml_gates(P, rowbase, c, hd, b_i[hd], b_f[hd], lane, logi, lf);
        const float b = wave_incl_sum(lf, lane), av = logi - b, Am = wave_incl_max(av, lane), Mx = fmaxf(mprev, Am);
        sA[lane] = av; sM[lane] = Mx; sI[lane] = fast_exp(mprev - Mx); sE[lane] = fast_exp(-(b + Mx));
    }
#pragma unroll
    for (int k2 = 0; k2 < 2; ++k2) { const int o = (sl + 32 * k2) * QS + scc * 16;
        *(LAS u32x4*)(lds + MLC_Q + o) = pq[k2]; *(LAS u32x4*)(lds + MLC_K + o) = pk[k2]; *(LAS u32x4*)(lds + MLC_V + o) = pv[k2]; *(LAS u32x4*)(lds + MLC_MO + o) = po[k2]; }
    LDSW();
    __syncthreads();
    {
        const int tok = 8 * wave + (lane >> 3), dch = lane & 7;
        const u32x4 q0 = *(const LAS u32x4*)(lds + MLC_Q + tok * QS + dch * 32), q1 = *(const LAS u32x4*)(lds + MLC_Q + tok * QS + dch * 32 + 16);
        float acc = 0.f;
#pragma unroll
        for (int j = 0; j < 4; ++j) { const f32x4 n4 = *(const LAS f32x4*)&sn[16 * dch + 4 * j]; const unsigned wa = j < 2 ? q0[2 * j] : q1[2 * j - 4], wb = j < 2 ? q0[2 * j + 1] : q1[2 * j - 3];
            acc += bf_lo(wa) * n4[0] + bf_hi(wa) * n4[1] + bf_lo(wb) * n4[2] + bf_hi(wb) * n4[3]; }
        acc += __shfl_xor(acc, 1); acc += __shfl_xor(acc, 2); acc += __shfl_xor(acc, 4);
        if (dch == 0) sqn[tok] = acc;
    }
    {
        const int lt = wave >> 1;
        bf16x8 qf[4];
#pragma unroll
        for (int kd = 0; kd < 4; ++kd) qf[kd] = *(const LAS bf16x8*)(lds + MLC_Q + (16 * lt + c16) * QS + (32 * kd + 8 * g4) * 2);
        const float Ml = sM[16 * lt + c16];
#pragma unroll
        for (int hh = 0; hh < 2; ++hh) { const int st = (wave & 1) + 2 * hh;
            u32x2 w = (u32x2){0u, 0u};
            if (st <= lt) {
                f32x4 ac = (f32x4){0.f, 0.f, 0.f, 0.f};
#pragma unroll
                for (int kd = 0; kd < 4; ++kd) { const bf16x8 kf = *(const LAS bf16x8*)(lds + MLC_K + (16 * st + c16) * QS + (32 * kd + 8 * g4) * 2); ac = __builtin_amdgcn_mfma_f32_16x16x32_bf16(kf, qf[kd], ac, 0, 0, 0); }
                const f32x4 a4 = *(const LAS f32x4*)&sA[16 * st + 4 * g4];
                float val[4];
#pragma unroll
                for (int r = 0; r < 4; ++r) { const int sI_ = 16 * st + 4 * g4 + r, l = 16 * lt + c16; val[r] = (sI_ <= l) ? fast_exp(a4[r] - Ml) * ac[r] * 0.08838834764831845f : 0.f; }
                w.x = cvt_pk_bf16(val[0], val[1]); w.y = cvt_pk_bf16(val[2], val[3]);
            }
            *(LAS u32x2*)(lds + MLC_W + (16 * lt + c16) * WS_ + (16 * st + 4 * g4) * 2) = w; }
    }
    LDSW();
    __syncthreads();
    {
        const int tok = 8 * wave + (lane >> 3), ch = lane & 7;
        const u32x4 w = *(const LAS u32x4*)(lds + MLC_W + tok * WS_ + ch * 16);
        float acc = (bf_lo(w.x) + bf_hi(w.x)) + (bf_lo(w.y) + bf_hi(w.y)) + (bf_lo(w.z) + bf_hi(w.z)) + (bf_lo(w.w) + bf_hi(w.w));
        acc += __shfl_xor(acc, 1); acc += __shfl_xor(acc, 2); acc += __shfl_xor(acc, 4);
        if (ch == 0) sR[tok] = acc;
    }
    f32x4 num[4];
    {
        bf16x8 vf[2];
#pragma unroll
        for (int ks = 0; ks < 2; ++ks) vf[ks] = tr_frag(lds + MLC_V, 32 * ks + 8 * g4, 32 * ks + 8 * g4 + 4, 16 * wave, c16);
#pragma unroll
        for (int lt = 0; lt < 4; ++lt) {
            f32x4 ah = (f32x4){0.f, 0.f, 0.f, 0.f}, aqc = (f32x4){0.f, 0.f, 0.f, 0.f};
#pragma unroll
            for (int ks = 0; ks < 2; ++ks) ah = __builtin_amdgcn_mfma_f32_16x16x32_bf16(*(const LAS bf16x8*)(lds + MLC_W + (16 * lt + c16) * WS_ + (32 * ks + 8 * g4) * 2), vf[ks], ah, 0, 0, 0);
#pragma unroll
            for (int kd = 0; kd < 4; ++kd) { const LAS unsigned char* qp = lds + MLC_Q + (16 * lt + c16) * QS + (32 * kd + 4 * g4) * 2;
                aqc = __builtin_amdgcn_mfma_f32_16x16x32_bf16(mk_frag(*(const LAS u32x2*)qp, *(const LAS u32x2*)(qp + 32)), __builtin_bit_cast(bf16x8, cfr[kd]), aqc, 0, 0, 0); }
            const f32x4 in4 = *(const LAS f32x4*)&sI[16 * lt + 4 * g4];
            num[lt] = in4 * aqc + ah;
        }
    }
    LDSW();
    __syncthreads();
#pragma unroll
    for (int lt = 0; lt < 4; ++lt) {
        const f32x4 qn4 = *(const LAS f32x4*)&sqn[16 * lt + 4 * g4], e4 = *(const LAS f32x4*)&sE[16 * lt + 4 * g4], in4 = *(const LAS f32x4*)&sI[16 * lt + 4 * g4], r4 = *(const LAS f32x4*)&sR[16 * lt + 4 * g4];
        f32x4 sq;
#pragma unroll
        for (int r = 0; r < 4; ++r) { const float den = in4[r] * qn4[r] + r4[r]; const float hv = num[lt][r] * __builtin_amdgcn_rcpf(fmaxf(fabsf(den), e4[r])); num[lt][r] = hv; sq[r] = hv * hv; }
#pragma unroll
        for (int o = 1; o < 16; o <<= 1) { sq[0] += __shfl_xor(sq[0], o); sq[1] += __shfl_xor(sq[1], o); sq[2] += __shfl_xor(sq[2], o); sq[3] += __shfl_xor(sq[3], o); }
        if (c16 == 0) *(LAS f32x4*)&sss[wave * 64 + 16 * lt + 4 * g4] = sq;
    }
    LDSW();
    __syncthreads();
#pragma unroll
    for (int lt = 0; lt < 4; ++lt) {
        f32x4 ss = (f32x4){0.f, 0.f, 0.f, 0.f};
#pragma unroll
        for (int w8 = 0; w8 < 8; ++w8) ss += *(const LAS f32x4*)&sss[w8 * 64 + 16 * lt + 4 * g4];
#pragma unroll
        for (int r = 0; r < 4; ++r) { const int l = 16 * lt + 4 * g4 + r; const int tt = 64 * c - 48 + l;
            const float mo = bf2f(*(const LAS unsigned short*)(lds + MLC_MO + l * QS + (16 * wave + c16) * 2));
            const float yv = num[lt][r] * __builtin_amdgcn_rsqf(ss[r] * (1.0f / 128.0f) + EPS) * gmh * sigmoidf_(mo);
            if (tt >= 0) YB[(rowbase + tt) * LDY + 1024 + hd * 128 + 16 * wave + c16] = (bf16_t)(cvt_pk_bf16(yv, 0.f) & 0xffffu); }
    }
}


struct Args { const float* in[12]; float* out; unsigned char* ws; };

__device__ __forceinline__ void convert_layer(const Args& a, int l, unsigned char* wgu0, unsigned char* wgu1, bf16_t* wdn0, bf16_t* wdn1, unsigned char* win, bf16_t* winb, bf16_t* wbr, bf16_t* wout, float* swgu0, float* swgu1, float* swin, LAS float* scr, int wave, int cblk, int G, int lane) {
    constexpr int N_GU8 = NGU / 32, N_IN8 = NWIN / 32, N_DN = (DM / 32) * (DFF / 64), N_BR1 = (DM / 32) * (512 / 64), N_OUT = (DM / 32) * (DM / 64), N_INB = (NWIN / 32) * (DM / 64);
    constexpr int NITEMS = 2 * N_GU8 + N_IN8 + 2 * N_DN + 3 * N_BR1 + N_OUT + N_INB;
    const float* sgu = a.in[3] + (size_t)l * 2 * DM * NGU; const float* sdn = a.in[4] + (size_t)l * 2 * DFF * DM;
    const float* sin_ = a.in[5] + (size_t)l * DM * INW; const float* sbr = a.in[10] + (size_t)l * 3 * 512 * DM; const float* sout = a.in[11] + (size_t)l * DM * DM;
    for (int it = wave * G + cblk; it < NITEMS; it += 8 * G) {
        int r = it;
        if (r < N_GU8) { cvt8_item(sgu, DM, NGU, wgu0, swgu0, scr, r, lane, map_gu); continue; } r -= N_GU8;
        if (r < N_GU8) { cvt8_item(sgu + (size_t)DM * NGU, DM, NGU, wgu1, swgu1, scr, r, lane, map_gu); continue; } r -= N_GU8;
        if (r < N_IN8) { cvt8_item(sin_, DM, INW, win, swin, scr, r, lane, map_win); continue; } r -= N_IN8;
        if (r < N_DN) { cvt_item(sdn, DFF, DM, wdn0, scr, r, lane, map_id); continue; } r -= N_DN;
        if (r < N_DN) { cvt_item(sdn + (size_t)DFF * DM, DFF, DM, wdn1, scr, r, lane, map_id); continue; } r -= N_DN;
        if (r < 3 * N_BR1) { const int br = r / N_BR1; cvt_item(sbr + (size_t)br * 512 * DM, 512, DM, wbr + (size_t)br * DM * 512, scr, r - br * N_BR1, lane, map_id); continue; } r -= 3 * N_BR1;
        if (r < N_OUT) { cvt_item(sout, DM, DM, wout, scr, r, lane, map_id); continue; } r -= N_OUT;
        cvt_item(sin_, DM, INW, winb, scr, r, lane, map_win);
    }
}

template <class Tp> __device__ __forceinline__ Tp* opq(Tp* p) { unsigned long long v = (unsigned long long)p; asm volatile("" : "+s"(v)); return (Tp*)(__attribute__((address_space(1))) Tp*)v; }
#define GRID_BAR() do { XcdBarrier b_ = bar; asm volatile("" : "+s"(b_.x)); xcd_barrier(b_); if (BAR_TWICE) xcd_barrier(b_); } while (0)

#define P_BEGIN(id) unsigned long long pt0_ = 0; if ((PROBE_ID >> (id)) & 1) pt0_ = __builtin_amdgcn_s_memrealtime();
#define P_END(id) if ((PROBE_ID >> (id)) & 1) { const unsigned long long pt1_ = __builtin_amdgcn_s_memrealtime(); const unsigned long long d_ = pt1_ - pt0_; while (__builtin_amdgcn_s_memrealtime() - pt1_ < d_) __builtin_amdgcn_s_sleep(8); GRID_BAR(); }

__global__ void __launch_bounds__(512, 2) fwd_kernel(Args a) {
    extern __shared__ __attribute__((aligned(16))) unsigned char lds_raw[];
    LAS unsigned char* lds = (LAS unsigned char*)lds_raw;
    const int wave = __builtin_amdgcn_readfirstlane((int)threadIdx.x >> 6);
    const int G = gridDim.x, c = blockIdx.x;
    const int gw = c * 8 + wave, NGW = G * 8;
    volatile LAS unsigned* MISC = (volatile LAS unsigned*)(lds + LDSCTL_OFF);
    if (wave == 0) MISC[fresh_lane()] = 0u;
#define lane fresh_lane()
#define tid (wave * 64 + fresh_lane())
    __syncthreads();
    XcdBarrier bar = xcd_barrier_post((unsigned*)(a.ws + WS_CTL) + CW_BAR, MISC, wave);
#define WSP(T_, off) ((T_*)(w_ + (off)))

    { P_BEGIN(19) { unsigned char* w_ = opq(a.ws);
      float* ctab = WSP(float, WS_COS); float* stab = WSP(float, WS_SIN);
      int tid0_ = tid; asm volatile("" : "+v"(tid0_));
      for (int i = c * 512 + tid0_; i < T * 32; i += G * 512) { const int t = i >> 5, j = i & 31;
          const float inv = 1.0f / powf(10000.0f, (float)(2 * j) / 64.0f); const float ang = (float)t * inv; ctab[i] = cosf(ang); stab[i] = sinf(ang); }
      convert_layer(a, 0, WSP(unsigned char, WS_WGU0), WSP(unsigned char, WS_WGU1), WSP(bf16_t, WS_WDN0), WSP(bf16_t, WS_WDN1), WSP(unsigned char, WS_WIN8), WSP(bf16_t, WS_WIN), WSP(bf16_t, WS_WBR), WSP(bf16_t, WS_WOUT), WSP(float, WS_SW), WSP(float, WS_SW) + 8192, WSP(float, WS_SW) + 16384, (LAS float*)(lds + wave * 16384), wave, c, G, lane);
      hres_t* H = WSP(hres_t, WS_H); unsigned char* U8 = (unsigned char*)opq(a.out); float* SU = WSP(float, WS_SU); const float* g0 = opq(a.in[2]);
      init_pass(a.in[0], a.in[1], H, U8, SU, g0, gw, NGW, lane); }
    GRID_BAR(); P_END(19) }

    int stage = 0;
#pragma unroll 1
    for (int l = 0; l < DEPTH; ++l) {
#pragma unroll 1
        for (int f = 0; f < 2; ++f) {
            if (stage >= DBG_STOP) break;
            { P_BEGIN(1) { unsigned char* w_ = opq(a.ws);
              pg8::Gemm gm{f ? (const char*)(w_ + WS_U8B) : (const char*)opq(a.out), nullptr, nullptr, (const char*)(w_ + (f ? WS_WGU1 : WS_WGU0)), 0, DM / 2, DM / 2, DM / 2, 0}; pg8::Sched S; S.init(M / 256, NGU / 256, 1, G, c);
              pg8::EpiSwiglu E{WSP(bf16_t, WS_BIG), DFF, WSP(float, WS_SU), WSP(float, WS_SW) + (f ? 8192 : 0)}; pg8::gemm_phase<pg8::EpiSwiglu, true>(lds, gm, S, E, wave); }
            GRID_BAR(); P_END(1) }
            { P_BEGIN(2) { unsigned char* w_ = opq(a.ws); pg8::Gemm gm{(const char*)(w_ + WS_BIG), nullptr, nullptr, (const char*)(w_ + (f ? WS_WDN1 : WS_WDN0)), 0, DFF, DFF, DFF, 0}; pg8::Sched S; S.init(MT / 256, DM / 256, 1, G, c);
              pg8::EpiBf16 E{WSP(bf16_t, WS_Y), DM}; pg8::gemm_phase(lds, gm, S, E, wave);
              pg8::Gemm gt{(const char*)(w_ + WS_BIG) + (size_t)MT * DFF * 2, nullptr, nullptr, (const char*)(w_ + (f ? WS_WDN1 : WS_WDN0)), 512, DFF, DFF, 256, 512}; pg8::Sched St; St.init(1, DM / 256, DFF / 256, G, c, true);
              pg8::EpiPartF32 Et{WSP(float, WS_YT), DM}; pg8::gemm_phase(lds, gt, St, Et, wave); }
            GRID_BAR(); P_END(2) }
            { P_BEGIN(3) { unsigned char* w_ = opq(a.ws); const bf16_t* Y = WSP(bf16_t, WS_Y); hres_t* H = WSP(hres_t, WS_H); unsigned char* U8 = (unsigned char*)opq(a.out); float* SU = WSP(float, WS_SU);
              const float* g = opq(a.in[2]) + (size_t)l * 6 * DM; const float* ga = g + (f ? 5 : 1) * DM;
              const float* gb = f ? opq(a.in[2]) + (size_t)(l + 1 < DEPTH ? l + 1 : l) * 6 * DM : g + 2 * DM;
              float* YT = WSP(float, WS_YT);
              norm_pass(Y, H, U8, SU, f ? nullptr : (bf16_t*)Y, ga, gb, 0.5f, gw, NGW, lane);
              for (int r = MT + gw; r < M; r += NGW) norm_row(Y + (size_t)r * DM, YT + (size_t)(r - MT) * DM, DFF / 256, H + (size_t)r * DM, U8 + (size_t)r * DM, SU + r, f ? nullptr : (bf16_t*)Y + (size_t)r * DM, ga, gb, 0.5f, lane);
              if (f == 1 && l + 1 < DEPTH) convert_layer(a, l + 1, WSP(unsigned char, WS_WGU0), WSP(unsigned char, WS_WGU1), WSP(bf16_t, WS_WDN0), WSP(bf16_t, WS_WDN1), WSP(unsigned char, WS_WIN8), WSP(bf16_t, WS_WIN), WSP(bf16_t, WS_WBR), WSP(bf16_t, WS_WOUT), WSP(float, WS_SW), WSP(float, WS_SW) + 8192, WSP(float, WS_SW) + 16384, (LAS float*)(lds + wave * 16384), wave, c, G, lane); }
            GRID_BAR(); P_END(3) }
            ++stage;
            if (f == 1) break;
            if (stage >= DBG_STOP) break;
#pragma unroll 1
            for (int hb = 0; hb < 2; ++hb) {
                { P_BEGIN(4) { unsigned char* w_ = opq(a.ws);
                  if (WIN_INT8) { pg8::Gemm gm{(const char*)opq(a.out) + (size_t)hb * MH * DM, nullptr, nullptr, (const char*)(w_ + WS_WIN8), 0, DM / 2, DM / 2, DM / 2, 0}; pg8::Sched S; S.init(MHP / 256, 20, 1, G, (c + G - (MHP / 256 * 11) % G) % G); S.pn0 = 6; S.gap_at = 4; S.gap = 5;
                    pg8::EpiWin E{WSP(bf16_t, WS_BIG), WSP(bf16_t, WS_GT), WSP(bf16_t, WS_KV), WSP(bf16_t, WS_KI), WSP(float, WS_COS), WSP(float, WS_SIN), WSP(float, WS_SU) + (size_t)hb * MH, WSP(float, WS_SW) + 16384}; pg8::gemm_phase<pg8::EpiWin, true>(lds, gm, S, E, wave); }
                  { pg8::Gemm gm{(const char*)(WSP(bf16_t, WS_Y) + (size_t)hb * MH * DM), nullptr, nullptr, (const char*)(w_ + WS_WIN), 0, DM, DM, DM, 0}; pg8::Sched S; S.init(MHP / 256, WIN_INT8 ? 11 : 31, 1, G, c); if (WIN_INT8) { S.gap_at = 6; S.gap = 4; }
                    pg8::EpiWin E{WSP(bf16_t, WS_BIG), WSP(bf16_t, WS_GT), WSP(bf16_t, WS_KV), WSP(bf16_t, WS_KI), WSP(float, WS_COS), WSP(float, WS_SIN), nullptr, nullptr}; pg8::gemm_phase(lds, gm, S, E, wave); } }
                GRID_BAR(); P_END(4) }
                { P_BEGIN(5) { unsigned char* w_ = opq(a.ws); unsigned* qbase = WSP(unsigned, WS_CTL) + CW_QUEUE + 64 * 8 * ((l * 2 + hb) * 2);
                  bf16_t* P = WSP(bf16_t, WS_BIG); unsigned char* ob = (unsigned char*)opq(a.out);
                  constexpr int N_ML = 260, N_SA = 257, N_CV = 33;
                  const int myq = (int)(bar.x & 7u);
                  constexpr unsigned NQ = N_ML + N_SA + N_CV;
                  int qoff = 0, itw;
                  __syncthreads();
                  if (tid == 0) { int it = -1, qq = 0; for (; qq < 8; ++qq) { const int qid = (myq + qq) & 7; const unsigned v = atomicAdd(qbase + 64 * qid, 1u); if (v < NQ) { it = (int)v | (qid << 16); break; } } MISC[4] = (unsigned)it; MISC[5] = (unsigned)qq; }
                  __syncthreads();
                  itw = (int)MISC[4]; qoff = (int)MISC[5];
                  while (itw >= 0) {
                      __syncthreads();
                      unsigned nv = 0u; const bool t0_ = (tid == 0);
                      if (t0_) nv = atomicAdd(qbase + 64 * ((myq + qoff) & 7), 1u);
                      const int item = itw & 0xffff, bl = itw >> 16;
                      unsigned long long it0_ = 0; if (PROBE_ID >> 9) it0_ = __builtin_amdgcn_s_memrealtime();
                      if (item < N_ML) mlA_item(lds, P, opq(a.in[7]) + l * 4, opq(a.in[8]) + l * 4, (bf16_t*)(ob + OB_CB), (float*)(ob + OB_NB), (float*)(ob + OB_SC), bl, item / 65, item % 65, tid, lane, wave);
                      else if (item < N_ML + N_SA) selattn_item(lds, P, (bf16_t*)(ob + OB_YB), WSP(bf16_t, WS_KV), WSP(bf16_t, WS_KI), bl, 256 - (item - N_ML), tid, lane, wave);
                      else conv_item(P, (bf16_t*)(ob + OB_YB), opq(a.in[6]) + (size_t)l * 3 * 512, bl, item - N_ML - N_SA, tid);
                      if (PROBE_ID >> 9) { const int kind = item < N_ML ? 9 : (item < N_ML + N_SA ? 10 : 11);
                          if ((PROBE_ID >> kind) & 1) { const unsigned long long it1_ = __builtin_amdgcn_s_memrealtime(); const unsigned long long d_ = it1_ - it0_; while (__builtin_amdgcn_s_memrealtime() - it1_ < d_) __builtin_amdgcn_s_sleep(8); } }
                      if (t0_) { int it = -1, qq = qoff; unsigned v = nv;
                          for (;;) { if (v < NQ) { it = (int)v | (((myq + qq) & 7) << 16); break; } if (++qq >= 8) break; v = atomicAdd(qbase + 64 * ((myq + qq) & 7), 1u); }
                          MISC[4] = (unsigned)it; MISC[5] = (unsigned)qq; }
                      __syncthreads();
                      itw = (int)MISC[4]; qoff = (int)MISC[5];
                  } }
                GRID_BAR(); P_END(5) }
                { P_BEGIN(17) { unsigned char* ob = (unsigned char*)opq(a.out);
                  mlB_scan((bf16_t*)(ob + OB_CB), (float*)(ob + OB_NB), (const float*)(ob + OB_SC), (float*)(ob + OB_MB), c, G * 512, wave); }
                GRID_BAR(); P_END(17) }
                { P_BEGIN(18) { unsigned char* w_ = opq(a.ws); unsigned* qbase = WSP(unsigned, WS_CTL) + CW_QUEUE + 64 * 8 * ((l * 2 + hb) * 2 + 1);
                  bf16_t* P = WSP(bf16_t, WS_BIG); unsigned char* ob = (unsigned char*)opq(a.out);
                  const int myq = (int)(bar.x & 7u);
                  int qoff = 0, itw;
                  __syncthreads();
                  if (tid == 0) { int it = -1, qq = 0; for (; qq < 8; ++qq) { const int qid = (myq + qq) & 7; const unsigned v = atomicAdd(qbase + 64 * qid, 1u); if (v < 260u) { it = (int)v | (qid << 16); break; } } MISC[4] = (unsigned)it; MISC[5] = (unsigned)qq; }
                  __syncthreads();
                  itw = (int)MISC[4]; qoff = (int)MISC[5];
                  while (itw >= 0) {
                      __syncthreads();
                      unsigned nv = 0u; const bool t0_ = (tid == 0);
                      if (t0_) nv = atomicAdd(qbase + 64 * ((myq + qoff) & 7), 1u);
                      const int item = itw & 0xffff, bl = itw >> 16;
                      mlC_item(lds, P, (bf16_t*)(ob + OB_YB), opq(a.in[7]) + l * 4, opq(a.in[8]) + l * 4, opq(a.in[9]) + (size_t)l * 512, (const bf16_t*)(ob + OB_CB), (const float*)(ob + OB_NB), (const float*)(ob + OB_MB), bl, item / 65, item % 65, tid, lane, wave);
                      if (t0_) { int it = -1, qq = qoff; unsigned v = nv;
                          for (;;) { if (v < 260u) { it = (int)v | (((myq + qq) & 7) << 16); break; } if (++qq >= 8) break; v = atomicAdd(qbase + 64 * ((myq + qq) & 7), 1u); }
                          MISC[4] = (unsigned)it; MISC[5] = (unsigned)qq; }
                      __syncthreads();
                      itw = (int)MISC[4]; qoff = (int)MISC[5];
                  } }
                GRID_BAR(); P_END(18) }
                { P_BEGIN(6) { unsigned char* w_ = opq(a.ws); bf16_t* P = WSP(bf16_t, WS_BIG);
                  const char* yb = (const char*)opq(a.out) + OB_YB;
                  pg8::Gemm gm{yb, nullptr, nullptr, (const char*)(w_ + WS_WBR), (size_t)DM * 512 * 2, LDY, 512, 512, 1024}; pg8::Sched S; S.init(128, DM / 256, 3, G, c);
                  pg8::EpiMerge E{WSP(bf16_t, WS_GT), WSP(bf16_t, WS_Y) + (size_t)hb * MH * DM, MH}; pg8::gemm_phase(lds, gm, S, E, wave);
                  pg8::Gemm gt{yb + (size_t)32768 * LDY * 2, nullptr, nullptr, (const char*)(w_ + WS_WBR), (size_t)DM * 512 * 2, LDY, 512, 512, 1024}; pg8::Sched St; St.init(1, DM / 256, 3, G, (c + G / 2) % G, true);
                  pg8::EpiGateSlab Et{WSP(bf16_t, WS_GT), WSP(float, WS_YT)}; pg8::gemm_phase(lds, gt, St, Et, wave); }
                GRID_BAR();
                { unsigned char* w_ = opq(a.ws); const f32x4* sl = WSP(f32x4, WS_YT); bf16_t* Yh = WSP(bf16_t, WS_Y) + ((size_t)hb * MH + 32768) * DM;
                  int ln = lane; asm volatile("" : "+v"(ln));
                  for (int r = gw; r < MH - 32768; r += NGW) {
#pragma unroll
                      for (int j = 0; j < 4; ++j) { const size_t o = (size_t)r * (DM / 4) + ln + 64 * j; const f32x4 v = sl[o] + sl[o + 256 * DM / 4] + sl[o + 2 * 256 * DM / 4];
                          u32x2 w; w.x = cvt_pk_bf16(v[0], v[1]); w.y = cvt_pk_bf16(v[2], v[3]); ((u32x2*)(Yh + (size_t)r * DM))[ln + 64 * j] = w; } } }
                if (hb == 1 || PROBE_ID) GRID_BAR();
                P_END(6) }
            }
            { P_BEGIN(7) { unsigned char* w_ = opq(a.ws); pg8::Gemm gm{(const char*)(w_ + WS_Y), nullptr, nullptr, (const char*)(w_ + WS_WOUT), 0, DM, DM, DM, 0}; pg8::Sched S; S.init(MT / 256, DM / 256, 1, G, c);
              pg8::EpiBf16 E{(bf16_t*)opq(a.out), DM}; pg8::gemm_phase(lds, gm, S, E, wave);
              pg8::Gemm gt{(const char*)(w_ + WS_Y) + (size_t)MT * DM * 2, nullptr, nullptr, (const char*)(w_ + WS_WOUT), 512, DM, DM, 256, 512}; pg8::Sched St; St.init(1, DM / 256, DM / 256, G, c, true);
              pg8::EpiPartF32 Et{WSP(float, WS_YT), DM}; pg8::gemm_phase(lds, gt, St, Et, wave); }
            GRID_BAR(); P_END(7) }
            { P_BEGIN(8) { unsigned char* w_ = opq(a.ws); hres_t* H = WSP(hres_t, WS_H); const bf16_t* U = (const bf16_t*)opq(a.out); unsigned char* U8 = WSP(unsigned char, WS_U8B); float* SU = WSP(float, WS_SU); const float* g = opq(a.in[2]) + (size_t)l * 6 * DM;
              float* YT = WSP(float, WS_YT);
              norm_pass(U, H, U8, SU, nullptr, g + 3 * DM, g + 4 * DM, 1.0f, gw, NGW, lane);
              for (int r = MT + gw; r < M; r += NGW) norm_row(U + (size_t)r * DM, YT + (size_t)(r - MT) * DM, DM / 256, H + (size_t)r * DM, U8 + (size_t)r * DM, SU + r, nullptr, g + 3 * DM, g + 4 * DM, 1.0f, lane); }
            GRID_BAR(); P_END(8) }
            ++stage;
        }
        if (stage >= DBG_STOP) break;
    }
    { P_BEGIN(20) { unsigned char* w_ = opq(a.ws); const hres_t* H = WSP(hres_t, WS_H); float* out = opq(a.out);
      int ln = lane; asm volatile("" : "+v"(ln));
      for (int r = gw; r < BATCH * SEQ; r += 4 * NGW) {
          h16x4 hv[4][4];
#pragma unroll
          for (int q = 0; q < 4; ++q) { const int rr = r + q * NGW; const int rc = rr < BATCH * SEQ ? rr : r; const int b = rc / SEQ, s = rc - b * SEQ;
              const h16x4* hrow = (const h16x4*)(H + ((size_t)b * T + NMETA + s) * DM);
#pragma unroll
              for (int j = 0; j < 4; ++j) hv[q][j] = hrow[ln + 64 * j]; }
#pragma unroll
          for (int q = 0; q < 4; ++q) { const int rr = r + q * NGW; if (rr < BATCH * SEQ) { f32x4* o = (f32x4*)(out + (size_t)rr * DM) + ln;
#pragma unroll
              for (int j = 0; j < 4; ++j) o[64 * j] = __builtin_convertvector(hv[q][j], f32x4); } } } }
      if (PROBE_ID) GRID_BAR();
      P_END(20) }
#undef WSP
#undef lane
#undef tid
}

extern "C" void kernel_launch(void* const* d_in, const int* in_sizes, int n_in, void* d_out, int out_size, void* d_ws, size_t ws_size, hipStream_t stream) {
    static int grid = 0;
    if (grid == 0) {
        if (n_in != 12 || out_size != BATCH * SEQ * DM || ws_size < WS_END) { fprintf(stderr, "kernel_launch: unexpected shapes (n_in %d, out %d, ws %zu)\n", n_in, out_size, ws_size); grid = -1; return; }
        int dev = 0, cus = 0, per_cu = 0;
        if (hipGetDevice(&dev) != hipSuccess || hipDeviceGetAttribute(&cus, hipDeviceAttributeMultiprocessorCount, dev) != hipSuccess) { grid = -1; return; }
        if (hipFuncSetAttribute((const void*)fwd_kernel, hipFuncAttributeMaxDynamicSharedMemorySize, LDS_BYTES) != hipSuccess) { fprintf(stderr, "kernel_launch: hipFuncSetAttribute failed\n"); grid = -1; return; }
        if (hipOccupancyMaxActiveBlocksPerMultiprocessor(&per_cu, (const void*)fwd_kernel, 512, LDS_BYTES) != hipSuccess || per_cu < 1) { fprintf(stderr, "kernel_launch: occupancy query says %d\n", per_cu); }
        (void)hipGetLastError();
        grid = cus;
    }
    if (grid < 0) return;
    (void)hipMemsetAsync((char*)d_ws + WS_CTL, 0, CTL_ZERO_BYTES, stream);
    Args a{};
    for (int i = 0; i < 12; ++i) a.in[i] = (const float*)d_in[i];
    a.out = (float*)d_out; a.ws = (unsigned char*)d_ws;
    hipLaunchKernelGGL(fwd_kernel, dim3(grid), dim3(512), LDS_BYTES, stream, a);
}
```

```cpp
#include <hip/hip_runtime.h>
#include <cstdio>
#include <cstdint>

#define LAS __attribute__((address_space(3)))
typedef unsigned short bf16_t;
typedef short bf16x8 __attribute__((ext_vector_type(8)));
typedef short bf16x4 __attribute__((ext_vector_type(4)));
typedef float f32x4 __attribute__((ext_vector_type(4)));
typedef float f32x2 __attribute__((ext_vector_type(2)));
typedef unsigned u32x4 __attribute__((ext_vector_type(4)));
typedef unsigned u32x2 __attribute__((ext_vector_type(2)));
typedef short s16x4 __attribute__((ext_vector_type(4)));
typedef int i32x4 __attribute__((ext_vector_type(4)));
typedef _Float16 hres_t;
typedef _Float16 h16x4 __attribute__((ext_vector_type(4)));

#ifndef PROBE_ID
#define PROBE_ID 0
#endif
#define FORCE_FALLBACK 0
#ifndef WIN_INT8
#define WIN_INT8 1
#endif
#define BAR_TWICE 0
#ifndef DBG_STOP
#define DBG_STOP 1000
#endif

constexpr int BATCH = 16, SEQ = 4096, DM = 1024, DEPTH = 4, NMETA = 16;
constexpr int T = SEQ + NMETA;
constexpr int M = BATCH * T;
constexpr int DFF = 2816, NGU = 2 * DFF;
constexpr int INW = 7756, NWIN = 7936, LDP = 4864;
constexpr int HBAT = 8;
constexpr int MH = HBAT * T;
constexpr int MHP = 129 * 256;
constexpr float EPS = 1e-6f;
constexpr int PC_CX = 0, PC_CB = 512, PC_CC = 1024, PC_Q = 1536, PC_QI = 2304, PC_WI = 2624, PC_MI = 2628, PC_MF = 2632;
constexpr int PC_MQ = 2816, PC_MK = 3328, PC_MV = 3840, PC_MO = 4352;
constexpr int SC_Q = 1536, SC_K = 2048, SC_V = 2176, SC_QI = 2304, SC_KI = 2560, SC_WI = 2624, SC_MQ = 2628, SC_MI = 4676, SC_MF = 4680, SC_GT = 4684;

constexpr size_t MiB = 1u << 20;
constexpr size_t WS_CTL = 0, CTL_ZERO_BYTES = 1 * MiB;
constexpr size_t WS_COS = 1 * MiB, WS_SIN = 2 * MiB;
constexpr size_t WS_SW = 5 * MiB;
constexpr size_t WS_SU = 6 * MiB;
constexpr size_t WS_U8B = 812 * MiB;
constexpr size_t WS_YT = 980 * MiB;
constexpr int MT = 256 * 256;
constexpr size_t WS_WGU0 = 8 * MiB, WS_WGU1 = 19 * MiB, WS_WDN0 = 30 * MiB, WS_WDN1 = 36 * MiB, WS_WIN = 42 * MiB, WS_WBR = 58 * MiB, WS_WOUT = 61 * MiB;
constexpr size_t WS_WIN8 = 64 * MiB;
constexpr size_t WS_H = 72 * MiB;
constexpr size_t WS_Y = 329 * MiB;
constexpr size_t WS_BIG = 458 * MiB;
constexpr size_t WS_KV = 958 * MiB;
constexpr size_t WS_KI = 975 * MiB;
constexpr size_t WS_END = 991 * MiB;
constexpr size_t WS_GT = WS_BIG + (size_t)MHP * LDP * 2;
static_assert(WS_GT % 256 == 0 && WS_GT + (size_t)(MHP / 256) * 12 * 131072 <= WS_KV && WS_KV + (size_t)MHP * 512 <= WS_KI && WS_KI + (size_t)MHP * 128 <= WS_YT && WS_YT + (size_t)11 * 256 * DM * 4 <= WS_END, "ws map");
static_assert(WS_H + (size_t)M * DM * 4 <= WS_Y && WS_Y + (size_t)(M + 128) * DM * 2 <= WS_BIG && WS_BIG + (size_t)M * DFF * 2 <= WS_KV, "ws map 2");
constexpr size_t OB_CB = 64 * MiB + 512 * 1024  , OB_NB = 130 * MiB  , OB_SC = 131 * MiB + 512 * 1024  , OB_MB = 131 * MiB + 768 * 1024  ;
constexpr size_t OB_YB = 132 * MiB;
constexpr int LDY = 1536;
constexpr int CW_BAR = 4096;
constexpr int CW_QUEUE = 16384;

constexpr int RING_BYTES = 131072;
constexpr int LDSCTL_OFF = RING_BYTES;
constexpr int LDS_SCL = LDSCTL_OFF + 1024;
constexpr int LDS_BYTES = RING_BYTES + 8192;

__device__ __forceinline__ int fresh_lane() { unsigned z = 0u; asm volatile("" : "+s"(z)); return (int)__builtin_amdgcn_mbcnt_hi(~0u, __builtin_amdgcn_mbcnt_lo(~0u, z)); }
__device__ __forceinline__ float bf_lo(unsigned w) { return __uint_as_float(w << 16); }
__device__ __forceinline__ float bf_hi(unsigned w) { return __uint_as_float(w & 0xffff0000u); }
__device__ __forceinline__ float bf2f(bf16_t b) { return __uint_as_float(((unsigned)b) << 16); }
__device__ __forceinline__ unsigned cvt_pk_bf16(float lo, float hi) { unsigned r; asm volatile("v_cvt_pk_bf16_f32 %0, %1, %2" : "=v"(r) : "v"(lo), "v"(hi)); return r; }
__device__ __forceinline__ float wave_sum(float v) {
#pragma unroll
    for (int o = 1; o < 64; o <<= 1) v += __shfl_xor(v, o);
    return v;
}
__device__ __forceinline__ float fast_exp(float x) { return __builtin_amdgcn_exp2f(x * 1.44269504089f); }
__device__ __forceinline__ float sigmoidf_(float x) { return __builtin_amdgcn_rcpf(1.0f + fast_exp(-x)); }

namespace pg8 {
constexpr int BM = 256, BK = 64, HALF = 128, HTB = HALF * BK * 2, STAGE_BYTES = 8 * HTB, NXCD = 8, WGM = 8;
__host__ __device__ __forceinline__ int lds_byte(int r, int c) { const int st = (r >> 4) * 2 + (c >> 5), rr = r & 15, cc = c & 31, ob = rr * 64 + cc * 2; return st * 1024 + (ob ^ (((ob >> 9) & 1) << 5)); }
__host__ __device__ __forceinline__ void stage_rc(int b, int& R, int& C) { const int st = b / 1024, sb = b % 1024, swz = sb ^ (((sb >> 9) & 1) << 5); R = (st >> 1) * 16 + swz / 64; C = (st & 1) * 32 + (swz % 64) / 2; }
__host__ __device__ __forceinline__ int perm32(int rho) { const int n = rho >> 4, i = rho & 15; return 8 * (i >> 2) + 4 * n + (i & 3); }

struct Unit { int pm, pn, z; };
struct Gemm { const char* A0; const char* A1; const char* A2; const char* Bt; size_t bzs; int lda, ldb, K; size_t azs;
    __device__ __forceinline__ const char* abase(int z) const { return azs ? A0 + (size_t)z * azs : (z == 0 ? A0 : (z == 1 ? A1 : A2)); } };
struct Sched {
    int nM, nN, nZ, nwg, G, c; bool flat; int pn0 = 0, gap_at = 1 << 30, gap = 0;
    __device__ __forceinline__ void init(int nM_, int nN_, int nZ_, int G_, int c_, bool flat_ = false) { nM = nM_; nN = nN_; nZ = nZ_; nwg = nM * nN; G = G_; c = c_; flat = flat_; }
    __device__ __forceinline__ bool next(int i, Unit& u) const {
        if (flat) { const long L = (long)i * G + c; if (L >= (long)nwg * nZ) return false; const int t = (int)(L / nZ); u.z = (int)(L - (long)t * nZ); u.pm = t / nN; u.pn = t - u.pm * nN; return true; }
        const int ti = i / nZ; u.z = i - ti * nZ;
        const long L = (long)ti * G + c; if (L >= nwg) return false;
        int wgid = (int)L; { const int q = nwg / NXCD, r = nwg % NXCD, xcd = wgid % NXCD, off = wgid / NXCD; wgid = (xcd < r ? xcd * (q + 1) : r * (q + 1) + (xcd - r) * q) + off; }
        const int nig = WGM * nN, gid = wgid / nig, fm = gid * WGM, gsz = (nM - fm) < WGM ? (nM - fm) : WGM;
        u.pm = fm + ((wgid % nig) % gsz); u.pn = (wgid % nig) / gsz; u.pn = pn0 + u.pn + (u.pn >= gap_at ? gap : 0); return true;
    }
};

template <class Epi, bool I8 = false>
__device__ __forceinline__ void gemm_phase(LAS unsigned char* lds, const Gemm g, const Sched& S, const Epi& E, int wave_id) {
    int tid_ = wave_id * 64 + fresh_lane(); asm volatile("" : "+v"(tid_));
    const int tid = tid_, wid = __builtin_amdgcn_readfirstlane(tid >> 6), lane = tid & 63, wr = wid >> 2, wc = wid & 3, fr = lane & 15, fq = lane >> 4;
    const int K = g.K, nt = K / BK;
    unsigned voffA[2], voffB[2];
#pragma unroll
    for (int i = 0; i < 2; ++i) { int R, C; stage_rc(tid * 16 + i * 8192, R, C); const int Rb = (R & ~31) + perm32(R & 31);
        voffA[i] = (unsigned)(R * g.lda + C) * 2u; voffB[i] = (unsigned)(Rb * g.ldb + C) * 2u; }
    const size_t kstep = (size_t)(BK * 2);
    const size_t hstepA = (size_t)HALF * g.lda * 2, hstepB = (size_t)HALF * g.ldb * 2;
    const size_t tstepA = 2 * hstepA, tstepB = 2 * hstepB;
    const unsigned ldsw = (unsigned)wid * 1024u;
    const int aoff = lds_byte(wr * 64 + fr, fq * 8), boff = lds_byte(wc * 32 + fr, fq * 8);
#define PG8_SA(b, h) (((b) * 2 + (h)) * HTB)
#define PG8_SB(b, h) ((4 + (b) * 2 + (h)) * HTB)
#define PG8_STAGE(bufoff, gbase, voff) do { _Pragma("unroll") for (int _i = 0; _i < 2; ++_i) \
        __builtin_amdgcn_global_load_lds((const unsigned*)((const char*)(gbase) + (voff)[_i]), (LAS unsigned*)(lds + (bufoff) + ldsw + _i * 8192), 16, 0, 0); } while (0)
#define PG8_LDA(dst, b, h) do { _Pragma("unroll") for (int m = 0; m < 4; ++m) _Pragma("unroll") for (int k = 0; k < 2; ++k) dst[m][k] = *(const LAS bf16x8*)(lds + PG8_SA(b, h) + aoff + m * 2048 + k * 1024); } while (0)
#define PG8_LDB(dst, b, h) do { _Pragma("unroll") for (int n = 0; n < 2; ++n) _Pragma("unroll") for (int k = 0; k < 2; ++k) dst[n][k] = *(const LAS bf16x8*)(lds + PG8_SB(b, h) + boff + n * 2048 + k * 1024); } while (0)
#define PG8_MMA(ai, bj, At, Bt) do { __builtin_amdgcn_s_setprio(1); _Pragma("unroll") for (int m = 0; m < 4; ++m) _Pragma("unroll") for (int n = 0; n < 2; ++n) _Pragma("unroll") for (int k = 0; k < 2; ++k) \
        acc[ai][bj][m][n] = I8 ? __builtin_bit_cast(f32x4, __builtin_amdgcn_mfma_i32_16x16x64_i8(__builtin_bit_cast(i32x4, Bt[n][k]), __builtin_bit_cast(i32x4, At[m][k]), __builtin_bit_cast(i32x4, acc[ai][bj][m][n]), 0, 0, 0)) \
                               : __builtin_amdgcn_mfma_f32_16x16x32_bf16(Bt[n][k], At[m][k], acc[ai][bj][m][n], 0, 0, 0); __builtin_amdgcn_s_setprio(0); } while (0)
#define PG8_WAIT_V(n) asm volatile("s_waitcnt vmcnt(" #n ")" ::: "memory")
#define PG8_WAIT_L(n) asm volatile("s_waitcnt lgkmcnt(" #n ")" ::: "memory")
#define PG8_BAR __builtin_amdgcn_s_barrier()
#define PG8_SCHED __builtin_amdgcn_sched_barrier(0)
    Unit cur, nxt; int ui = 0;
    if (!S.next(0, cur)) return;
    f32x4 acc[2][2][4][2];
#pragma unroll
    for (int a = 0; a < 2; ++a)
#pragma unroll
        for (int b = 0; b < 2; ++b)
#pragma unroll
            for (int m = 0; m < 4; ++m)
#pragma unroll
                for (int n = 0; n < 2; ++n) acc[a][b][m][n] = (f32x4){0.f, 0.f, 0.f, 0.f};
    bf16x8 At[4][2], B0[2][2], B1[2][2];
    const char* cA = g.abase(cur.z) + (size_t)cur.pm * tstepA; const char* cB = g.Bt + (size_t)cur.z * g.bzs + (size_t)cur.pn * tstepB;
    PG8_STAGE(PG8_SB(0, 0), cB, voffB); PG8_STAGE(PG8_SA(0, 0), cA, voffA); PG8_STAGE(PG8_SB(0, 1), cB + hstepB, voffB); PG8_STAGE(PG8_SA(0, 1), cA + hstepA, voffA);
    if (wr == 1) PG8_BAR;
    PG8_WAIT_V(4); PG8_BAR;
    PG8_STAGE(PG8_SB(1, 0), cB + kstep, voffB); PG8_STAGE(PG8_SA(1, 0), cA + kstep, voffA); PG8_STAGE(PG8_SB(1, 1), cB + hstepB + kstep, voffB);
    PG8_WAIT_V(6); PG8_BAR;
    for (;;) {
        const bool has_next = S.next(ui + 1, nxt);
        const char* nA = has_next ? g.abase(nxt.z) + (size_t)nxt.pm * tstepA : cA; const char* nB = has_next ? g.Bt + (size_t)nxt.z * g.bzs + (size_t)nxt.pn * tstepB : cB;
        for (int t = 0; t < nt; t += 2) {
            const bool last = (t == nt - 2);
            if (last) E.pre(lds, cur, wid, lane);
            const char* a1 = cA + (size_t)(t + 1) * kstep;
            const char* a2 = last ? nA : cA + (size_t)(t + 2) * kstep; const char* b2 = last ? nB : cB + (size_t)(t + 2) * kstep;
            const char* a3 = a2 + kstep; const char* b3 = b2 + kstep;
            PG8_LDB(B0, 0, 0); PG8_SCHED; PG8_LDA(At, 0, 0); PG8_STAGE(PG8_SA(1, 1), a1 + hstepA, voffA);
            PG8_WAIT_L(8); PG8_BAR; PG8_WAIT_L(0); PG8_MMA(0, 0, At, B0); PG8_BAR; PG8_SCHED;
            PG8_LDB(B1, 0, 1); PG8_STAGE(PG8_SB(0, 0), b2, voffB);
            PG8_BAR; PG8_WAIT_L(0); PG8_MMA(0, 1, At, B1); PG8_BAR;
            PG8_LDA(At, 0, 1); PG8_STAGE(PG8_SA(0, 0), a2, voffA);
            PG8_BAR; PG8_WAIT_L(0); PG8_MMA(1, 0, At, B0); PG8_BAR; PG8_SCHED;
            PG8_STAGE(PG8_SB(0, 1), b2 + hstepB, voffB);
            PG8_WAIT_V(6); PG8_BAR; PG8_MMA(1, 1, At, B1); PG8_BAR;
            PG8_LDB(B0, 1, 0); PG8_SCHED; PG8_LDA(At, 1, 0); PG8_STAGE(PG8_SA(0, 1), a2 + hstepA, voffA);
            PG8_WAIT_L(8); PG8_BAR; PG8_WAIT_L(0); PG8_MMA(0, 0, At, B0); PG8_BAR; PG8_SCHED;
            PG8_LDB(B1, 1, 1); PG8_STAGE(PG8_SB(1, 0), b3, voffB);
            PG8_BAR; PG8_WAIT_L(0); PG8_MMA(0, 1, At, B1); PG8_BAR;
            PG8_LDA(At, 1, 1); PG8_STAGE(PG8_SA(1, 0), a3, voffA);
            PG8_BAR; PG8_WAIT_L(0); PG8_MMA(1, 0, At, B0); PG8_BAR; PG8_SCHED;
            PG8_STAGE(PG8_SB(1, 1), b3 + hstepB, voffB);
            PG8_WAIT_V(6); PG8_BAR; PG8_MMA(1, 1, At, B1); PG8_BAR;
        }
        const bool zero = E(acc, cur, wr, wc, fr, fq);
        if (!has_next) break;
        if (zero) {
#pragma unroll
            for (int a = 0; a < 2; ++a)
#pragma unroll
                for (int b = 0; b < 2; ++b)
#pragma unroll
                    for (int m = 0; m < 4; ++m)
#pragma unroll
                        for (int n = 0; n < 2; ++n) acc[a][b][m][n] = (f32x4){0.f, 0.f, 0.f, 0.f};
        }
        cur = nxt; cA = nA; cB = nB; ++ui;
    }
    PG8_WAIT_V(0);
    if (wr == 0) PG8_BAR;
    PG8_BAR;
#undef PG8_SA
#undef PG8_SB
#undef PG8_STAGE
#undef PG8_LDA
#undef PG8_LDB
#undef PG8_MMA
#undef PG8_WAIT_V
#undef PG8_WAIT_L
#undef PG8_BAR
#undef PG8_SCHED
}

__device__ __forceinline__ u32x4 pack8(const f32x4 a, const f32x4 b) { u32x4 w; w.x = cvt_pk_bf16(a[0], a[1]); w.y = cvt_pk_bf16(a[2], a[3]); w.z = cvt_pk_bf16(b[0], b[1]); w.w = cvt_pk_bf16(b[2], b[3]); return w; }

__device__ __forceinline__ void scl_pre(LAS unsigned char* lds, const Unit& u, int wid, int lane, const float* su, const float* sw) {
    const float* src = wid < 4 ? su + (size_t)u.pm * BM + wid * 64 + lane : sw + (size_t)u.pn * BM + (wid - 4) * 64 + lane;
    __builtin_amdgcn_global_load_lds((const unsigned*)src, (LAS unsigned*)(lds + LDS_SCL + wid * 256), 4, 0, 0);
}
__device__ __forceinline__ void dequant_acc(f32x4 (&acc)[2][2][4][2], const Unit& u, int wr, int wc, int fr, int fq, LAS unsigned char* lds) {
    const LAS float* su = (const LAS float*)(lds + LDS_SCL); const LAS float* sw = su + 256;
    const int row0 = wr * 64 + fr, col0 = wc * 32 + 8 * fq;
    f32x4 cs[2][2];
#pragma unroll
    for (int bj = 0; bj < 2; ++bj)
#pragma unroll
        for (int n = 0; n < 2; ++n) cs[bj][n] = *(const LAS f32x4*)(sw + col0 + bj * HALF + 4 * n);
    float rsv[2][4];
#pragma unroll
    for (int ai = 0; ai < 2; ++ai)
#pragma unroll
        for (int m = 0; m < 4; ++m) rsv[ai][m] = su[row0 + ai * HALF + m * 16];
    asm volatile("" : "+v"(rsv[0][0]), "+v"(rsv[0][1]), "+v"(rsv[0][2]), "+v"(rsv[0][3]), "+v"(rsv[1][0]), "+v"(rsv[1][1]), "+v"(rsv[1][2]), "+v"(rsv[1][3]));
#pragma unroll
    for (int ai = 0; ai < 2; ++ai)
#pragma unroll
        for (int m = 0; m < 4; ++m) { const float rs = rsv[ai][m];
#pragma unroll
            for (int bj = 0; bj < 2; ++bj)
#pragma unroll
                for (int n = 0; n < 2; ++n) { const i32x4 iv = __builtin_bit_cast(i32x4, acc[ai][bj][m][n]);
                    acc[ai][bj][m][n] = (f32x4){(float)iv[0], (float)iv[1], (float)iv[2], (float)iv[3]} * cs[bj][n] * rs; } }
}
struct EpiBf16 {
    bf16_t* O; int ldc;
    __device__ __forceinline__ void pre(LAS unsigned char*, const Unit&, int, int) const {}
    __device__ __forceinline__ bool operator()(f32x4 (&acc)[2][2][4][2], const Unit& u, int wr, int wc, int fr, int fq) const {
        const int row0 = u.pm * BM + wr * 64 + fr, col0 = u.pn * BM + wc * 32 + 8 * fq;
#pragma unroll
        for (int ai = 0; ai < 2; ++ai)
#pragma unroll
            for (int m = 0; m < 4; ++m) { bf16_t* rowp = O + (size_t)(row0 + ai * HALF + m * 16) * ldc + col0;
#pragma unroll
                for (int bj = 0; bj < 2; ++bj) *(u32x4*)(rowp + bj * HALF) = pack8(acc[ai][bj][m][0], acc[ai][bj][m][1]); }
        return true;
    }
};
struct EpiSwiglu {
    bf16_t* O; int ldc; const float* su; const float* sw; LAS unsigned char* lds;
    __device__ __forceinline__ void pre(LAS unsigned char* l, const Unit& u, int wid, int lane) const { if (su) scl_pre(l, u, wid, lane, su, sw); }
    __device__ __forceinline__ bool operator()(f32x4 (&acc)[2][2][4][2], const Unit& u, int wr, int wc, int fr, int fq) const {
        if (su) dequant_acc(acc, u, wr, wc, fr, fq, lds);
        const int row0 = u.pm * BM + wr * 64 + fr, col0 = u.pn * HALF + wc * 32 + 8 * fq;
#pragma unroll
        for (int ai = 0; ai < 2; ++ai)
#pragma unroll
            for (int m = 0; m < 4; ++m) { bf16_t* rowp = O + (size_t)(row0 + ai * HALF + m * 16) * ldc + col0;
                f32x4 o[2];
#pragma unroll
                for (int n = 0; n < 2; ++n)
#pragma unroll
                    for (int j = 0; j < 4; ++j) { const float gt = acc[ai][0][m][n][j], up = acc[ai][1][m][n][j]; o[n][j] = gt * sigmoidf_(gt) * up; }
                *(u32x4*)rowp = pack8(o[0], o[1]); }
        return true;
    }
};
struct EpiPartF32 {
    float* C; int ldc;
    __device__ __forceinline__ void pre(LAS unsigned char*, const Unit&, int, int) const {}
    __device__ __forceinline__ bool operator()(f32x4 (&acc)[2][2][4][2], const Unit& u, int wr, int wc, int fr, int fq) const {
        const int row0 = u.pm * BM + wr * 64 + fr, col0 = u.pn * BM + wc * 32 + 8 * fq;
        float* slab = C + (size_t)u.z * 256 * ldc;
#pragma unroll
        for (int ai = 0; ai < 2; ++ai)
#pragma unroll
            for (int m = 0; m < 4; ++m) { float* rowp = slab + (size_t)(row0 + ai * HALF + m * 16) * ldc + col0;
#pragma unroll
                for (int bj = 0; bj < 2; ++bj) { *(f32x4*)(rowp + bj * HALF) = acc[ai][bj][m][0]; *(f32x4*)(rowp + bj * HALF + 4) = acc[ai][bj][m][1]; } }
        return true;
    }
};
__device__ __forceinline__ size_t gt_off(int pm, int gn, int wr, int wc, int fr, int fq) { return ((size_t)pm * 12 + gn) * 65536 + (size_t)(((wr * 4 + wc) * 4 + fq) * 16 + fr) * 8; }
struct EpiWin {
    bf16_t* P; bf16_t* GT; bf16_t* KV; bf16_t* KI; const float* ctab; const float* stab; const float* su; const float* sw; LAS unsigned char* lds;
    __device__ __forceinline__ void pre(LAS unsigned char* l, const Unit& u, int wid, int lane) const { if (su) scl_pre(l, u, wid, lane, su, sw); }
    __device__ __forceinline__ bool operator()(f32x4 (&acc)[2][2][4][2], const Unit& u, int wr, int wc, int fr, int fq) const {
        if (su) dequant_acc(acc, u, wr, wc, fr, fq, lds);
        const int row0 = u.pm * BM + wr * 64 + fr; const int pn = u.pn;
        const bool rope_tile = (pn >= 6 && pn <= 10);
        if (!rope_tile) {
            const int col0 = pn * BM + wc * 32 + 8 * fq;
            if (pn >= 19) {
                bf16_t* gt = GT + gt_off(u.pm, pn - 19, wr, wc, fr, fq);
#pragma unroll
                for (int ai = 0; ai < 2; ++ai)
#pragma unroll
                    for (int m = 0; m < 4; ++m)
#pragma unroll
                        for (int bj = 0; bj < 2; ++bj) { f32x4 v0 = acc[ai][bj][m][0], v1 = acc[ai][bj][m][1];
#pragma unroll
                            for (int j = 0; j < 4; ++j) { v0[j] = sigmoidf_(v0[j]); v1[j] = sigmoidf_(v1[j]); }
                            *(u32x4*)(gt + ((ai * 4 + m) * 2 + bj) * 4096) = pack8(v0, v1); }
                return true;
            }
#pragma unroll
            for (int ai = 0; ai < 2; ++ai)
#pragma unroll
                for (int m = 0; m < 4; ++m) { bf16_t* rowp = P + (size_t)(row0 + ai * HALF + m * 16) * LDP + col0;
#pragma unroll
                    for (int bj = 0; bj < 2; ++bj) *(u32x4*)(rowp + bj * HALF) = pack8(acc[ai][bj][m][0], acc[ai][bj][m][1]); }
            return true;
        }
        bool do_rope = true, skip = false; bf16_t* dbase; int dld, dcol;
        if (pn == 6 || pn == 7) { dbase = P; dld = LDP; dcol = PC_Q + (4 * (pn - 6) + wc) * 64; }
        else if (pn == 8) { dbase = KV; dld = 256; if (wc < 2) dcol = wc * 64; else { dcol = 128 + (wc - 2) * 64; do_rope = false; } }
        else if (pn == 9) { dbase = P; dld = LDP; dcol = PC_QI + wc * 64; }
        else { if (wc == 0) { dbase = KI; dld = 64; dcol = 0; } else if (wc == 1) { dbase = P; dld = LDP; dcol = PC_WI; do_rope = false; } else { dbase = P; dld = LDP; dcol = 0; skip = true; } }
        if (skip) return true;
#pragma unroll
        for (int am = 0; am < 4; ++am) { const int ai = am >> 1;
            f32x4 tc0[2], tc1[2], ts0[2], ts1[2];
            if (do_rope) {
#pragma unroll
                for (int mm = 0; mm < 2; ++mm) { const int t = (row0 + ai * HALF + (2 * (am & 1) + mm) * 16) % T; const float* cp = ctab + t * 32 + 8 * fq; const float* sp = stab + t * 32 + 8 * fq;
                    tc0[mm] = *(const f32x4*)cp; tc1[mm] = *(const f32x4*)(cp + 4); ts0[mm] = *(const f32x4*)sp; ts1[mm] = *(const f32x4*)(sp + 4); }
            }
#pragma unroll
            for (int mm = 0; mm < 2; ++mm) { const int m = 2 * (am & 1) + mm;
                const int rl = row0 + ai * HALF + m * 16;
                bf16_t* dp = dbase + (size_t)rl * dld + dcol + 8 * fq;
                f32x4 x1a = acc[ai][0][m][0], x1b = acc[ai][0][m][1], x2a = acc[ai][1][m][0], x2b = acc[ai][1][m][1];
                if (do_rope) {
                    const f32x4 c0 = tc0[mm], c1 = tc1[mm], s0 = ts0[mm], s1 = ts1[mm];
                    const f32x4 o1a = x1a * c0 - x2a * s0, o1b = x1b * c1 - x2b * s1, o2a = x1a * s0 + x2a * c0, o2b = x1b * s1 + x2b * c1;
                    *(u32x4*)dp = pack8(o1a, o1b); *(u32x4*)(dp + 32) = pack8(o2a, o2b);
                } else if (pn == 8) {
                    *(u32x4*)dp = pack8(x1a, x1b); *(u32x4*)(dp + 32) = pack8(x2a, x2b);
                } else {
                    *(u32x4*)dp = pack8(x1a, x1b);
                }
            }
        }
        return true;
    }
};
struct EpiGateSlab {
    const bf16_t* GT; float* C;
    __device__ __forceinline__ void pre(LAS unsigned char*, const Unit&, int, int) const {}
    __device__ __forceinline__ bool operator()(f32x4 (&acc)[2][2][4][2], const Unit& u, int wr, int wc, int fr, int fq) const {
        asm volatile("" : "+v"(fr));
        const int row0 = wr * 64 + fr, col0 = u.pn * BM + wc * 32 + 8 * fq; const int z = u.z;
        float* slab = C + (size_t)z * 256 * DM;
#pragma unroll
        for (int ai = 0; ai < 2; ++ai) {
            u32x4 gzv[4][2];
#pragma unroll
            for (int m = 0; m < 4; ++m)
#pragma unroll
                for (int bj = 0; bj < 2; ++bj) gzv[m][bj] = *(const u32x4*)(GT + gt_off(128, 4 * z + u.pn, wr, wc, fr, fq) + ((ai * 4 + m) * 2 + bj) * 4096);
#pragma unroll
            for (int m = 0; m < 4; ++m) { float* rowp = slab + (size_t)(row0 + ai * HALF + m * 16) * DM + col0;
#pragma unroll
                for (int bj = 0; bj < 2; ++bj) { const u32x4 gz = gzv[m][bj];
                    const f32x4 g0 = (f32x4){bf_lo(gz[0]), bf_hi(gz[0]), bf_lo(gz[1]), bf_hi(gz[1])}, g1 = (f32x4){bf_lo(gz[2]), bf_hi(gz[2]), bf_lo(gz[3]), bf_hi(gz[3])};
                    *(f32x4*)(rowp + bj * HALF) = acc[ai][bj][m][0] * g0; *(f32x4*)(rowp + bj * HALF + 4) = acc[ai][bj][m][1] * g1; } }
        }
        return true;
    }
};
struct EpiMerge {
    const bf16_t* GT; bf16_t* O; int nrows;
    __device__ __forceinline__ void pre(LAS unsigned char*, const Unit&, int, int) const {}
    __device__ __forceinline__ float rinv(float gnext) const { return __builtin_amdgcn_rcpf(fmaxf(gnext, 1e-12f)); }
    __device__ __forceinline__ bool operator()(f32x4 (&acc)[2][2][4][2], const Unit& u, int wr, int wc, int fr, int fq) const {
        const int row0 = u.pm * BM + wr * 64 + fr, col0 = u.pn * BM + wc * 32 + 8 * fq; const int z = u.z;
        const bf16_t* gz_ = GT + gt_off(u.pm, 4 * z + u.pn, wr, wc, fr, fq); const bf16_t* gn_ = GT + gt_off(u.pm, 4 * (z < 2 ? z + 1 : z) + u.pn, wr, wc, fr, fq);
#pragma unroll
        for (int ai = 0; ai < 2; ++ai) {
            u32x4 gzv[4][2], gnv[4][2];
#pragma unroll
            for (int m = 0; m < 4; ++m)
#pragma unroll
                for (int bj = 0; bj < 2; ++bj) { gzv[m][bj] = *(const u32x4*)(gz_ + ((ai * 4 + m) * 2 + bj) * 4096); gnv[m][bj] = *(const u32x4*)(gn_ + ((ai * 4 + m) * 2 + bj) * 4096); }
#pragma unroll
            for (int m = 0; m < 4; ++m) { const size_t rl = (size_t)(row0 + ai * HALF + m * 16);
#pragma unroll
                for (int bj = 0; bj < 2; ++bj) {
                    const u32x4 gz = gzv[m][bj], gn = gnv[m][bj];
                    float f[8];
                    if (z < 2) {
#pragma unroll
                        for (int j = 0; j < 4; ++j) { f[2 * j] = fmaxf(bf_lo(gz[j]), z ? 1e-12f : 0.f) * rinv(bf_lo(gn[j])); f[2 * j + 1] = fmaxf(bf_hi(gz[j]), z ? 1e-12f : 0.f) * rinv(bf_hi(gn[j])); }
                    } else {
#pragma unroll
                        for (int j = 0; j < 4; ++j) { f[2 * j] = fmaxf(bf_lo(gz[j]), 1e-12f); f[2 * j + 1] = fmaxf(bf_hi(gz[j]), 1e-12f); }
                    }
#pragma unroll
                    for (int j = 0; j < 4; ++j) { acc[ai][bj][m][0][j] *= f[j]; acc[ai][bj][m][1][j] *= f[4 + j]; }
                    if (z == 2 && (int)rl < nrows) *(u32x4*)(O + rl * DM + col0 + bj * HALF) = pack8(acc[ai][bj][m][0], acc[ai][bj][m][1]);
                } }
        }
        return z == 2;
    }
};
}

#define XB_TMO      128
#define XB_XCNT(j)  (256  + 64 * (j))
#define XB_XSUB(j)  (1280 + 64 * (j))
#define XB_XGEN(j)  (2304 + 64 * (j))
#define XB_TOP      3328
#define XB_TOPGEN   3392
#define XCD_BAR_WORDS 3456
#define XB_SPIN_CAP (1u << 22)
__device__ __forceinline__ unsigned xb_ld(unsigned* p)              { return __hip_atomic_load(p, __ATOMIC_RELAXED, __HIP_MEMORY_SCOPE_AGENT); }
__device__ __forceinline__ unsigned xb_add(unsigned* p, unsigned v) { return __hip_atomic_fetch_add(p, v, __ATOMIC_RELAXED, __HIP_MEMORY_SCOPE_AGENT); }
__device__ __forceinline__ unsigned xb_xcc_id() { return (unsigned)__builtin_amdgcn_s_getreg((3 << 11) | 20) & 0xFu; }
#define XB_SPIN(cond, bar) do { unsigned _sp = 0; while (cond) { __builtin_amdgcn_s_sleep(1); \
    if ((++_sp & 255u) == 0u) { if (xb_ld(&(bar)[XB_TMO])) break; if (_sp > XB_SPIN_CAP) { atomicAdd(&(bar)[XB_TMO], 1u); break; } } } } while (0)
struct XcdBarrier { unsigned* bar; unsigned x; volatile LAS unsigned* st; int wv; };
__device__ __forceinline__ XcdBarrier xcd_barrier_post(unsigned* bar, volatile LAS unsigned* st, int wv) {
    XcdBarrier b; b.bar = bar; b.x = xb_xcc_id(); b.st = st; b.wv = wv;
    if (wv == 0 && fresh_lane() == 0) (void)xb_add(&bar[XB_XCNT(b.x)], 1u);
    return b;
}
__device__ __forceinline__ void xcd_barrier_complete(unsigned* bar, unsigned x, unsigned& nloc, unsigned& nx) {
    const unsigned G = gridDim.x * gridDim.y * gridDim.z;
    unsigned sum, cnt, mine, sp = 0u;
    for (;;) {
        sum = 0u; cnt = 0u; mine = 0u;
#pragma unroll
        for (unsigned j = 0; j < 16; ++j) { const unsigned c = xb_ld(&bar[XB_XCNT(j)]); sum += c; cnt += (c > 0u) ? 1u : 0u; mine = (j == x) ? c : mine; }
        if (sum == G) break;
        __builtin_amdgcn_s_sleep(1);
        if ((++sp & 255u) == 0u) { if (xb_ld(&bar[XB_TMO])) break; if (sp > XB_SPIN_CAP) { atomicAdd(&bar[XB_TMO], 1u); break; } }
    }
    nloc = mine > 0u ? mine : 1u; nx = cnt > 0u ? cnt : 1u;
}
__device__ __forceinline__ void xcd_barrier(const XcdBarrier& b) {
    asm volatile("s_waitcnt vmcnt(0)" ::: "memory");
    __syncthreads();
    if (b.wv == 0 && fresh_lane() == 0) {
        unsigned* bar = b.bar;
        __builtin_amdgcn_s_waitcnt(0);
        unsigned nloc = b.st[0], nx = b.st[1];
        if (nloc == 0u) { xcd_barrier_complete(bar, b.x, nloc, nx); b.st[0] = nloc; b.st[1] = nx; }
        const unsigned old = xb_add(&bar[XB_XSUB(b.x)], 1u);
        const unsigned gen = old / nloc;
        if (old + 1u == (gen + 1u) * nloc) {
            __builtin_amdgcn_fence(__ATOMIC_RELEASE, "agent");
            asm volatile("s_waitcnt vmcnt(0)" ::: "memory");
            const unsigned og = xb_add(&bar[XB_TOP], 1u);
            const unsigned tg = og / nx;
            if (og + 1u == (tg + 1u) * nx) xb_add(&bar[XB_TOPGEN], 1u);
            else XB_SPIN(xb_ld(&bar[XB_TOPGEN]) == tg, bar);
            __builtin_amdgcn_fence(__ATOMIC_ACQUIRE, "agent");
            xb_add(&bar[XB_XGEN(b.x)], 1u);
            asm volatile("s_waitcnt vmcnt(0)" ::: "memory");
        } else {
            XB_SPIN(xb_ld(&bar[XB_XGEN(b.x)]) == gen, bar);
            __builtin_amdgcn_fence(__ATOMIC_ACQUIRE, "agent");
            asm volatile("s_waitcnt vmcnt(0)" ::: "memory");
        }
    }
    __syncthreads();
}

template <class Map>
__device__ __forceinline__ void cvt_item(const float* W, int K, int N, bf16_t* WT, LAS float* scr, int item, int lane, Map srccol) {
    asm volatile("" : "+v"(lane));
    const int nkb = K / 64, rb = item / nkb, kb = item % nkb, k0 = 64 * kb, r0 = 32 * rb;
    const int sc = srccol(r0 + (lane & 31)); const int scc = sc >= 0 ? sc : 0;
    { float v[32];
#pragma unroll
      for (int i = 0; i < 32; ++i) v[i] = W[(size_t)(k0 + 2 * i + (lane >> 5)) * N + scc];
#pragma unroll
      for (int i = 0; i < 32; ++i) { const int kk = 2 * i + (lane >> 5); scr[kk * 33 + (lane & 31)] = sc >= 0 ? v[i] : 0.f; } }
    asm volatile("s_waitcnt lgkmcnt(0)" ::: "memory");
    const int c = lane & 7;
#pragma unroll
    for (int j = 0; j < 4; ++j) { const int n = (lane >> 3) + 8 * j; const LAS float* s = scr + (8 * c) * 33 + n;
        u32x4 o; o.x = cvt_pk_bf16(s[0 * 33], s[1 * 33]); o.y = cvt_pk_bf16(s[2 * 33], s[3 * 33]); o.z = cvt_pk_bf16(s[4 * 33], s[5 * 33]); o.w = cvt_pk_bf16(s[6 * 33], s[7 * 33]);
        *(u32x4*)(WT + (size_t)(r0 + n) * K + k0 + 8 * c) = o; }
    asm volatile("s_waitcnt lgkmcnt(0)" ::: "memory");
}
__device__ __forceinline__ unsigned pack_i8x4(float a, float b, float c, float d);
template <class Map>
__device__ __forceinline__ void cvt8_item(const float* W, int K, int N, unsigned char* W8, float* sw, LAS float* scr, int item, int lane, Map srccol) {
    asm volatile("" : "+v"(lane));
    const int r0 = 32 * item, nkb = K / 64;
    const int sc = srccol(r0 + (lane & 31)); const int scc = sc >= 0 ? sc : 0;
    float am = 0.f;
#pragma unroll 1
    for (int kb = 0; kb < nkb; ++kb) { float v[32];
#pragma unroll
        for (int i = 0; i < 32; ++i) v[i] = W[(size_t)(64 * kb + 2 * i + (lane >> 5)) * N + scc];
#pragma unroll
        for (int i = 0; i < 32; ++i) am = fmaxf(am, fabsf(v[i])); }
    am = sc >= 0 ? am : 0.f;
    am = fmaxf(am, __shfl_xor(am, 32));
    const float inv = am > 0.f ? 127.0f / am : 0.f;
    if (lane < 32) sw[r0 + lane] = am * (1.0f / 127.0f);
#pragma unroll 1
    for (int kb = 0; kb < nkb; ++kb) { const int k0 = 64 * kb;
        { float v[32];
#pragma unroll
          for (int i = 0; i < 32; ++i) v[i] = W[(size_t)(k0 + 2 * i + (lane >> 5)) * N + scc];
#pragma unroll
          for (int i = 0; i < 32; ++i) { const int kk = 2 * i + (lane >> 5); scr[kk * 33 + (lane & 31)] = v[i] * inv; } }
        asm volatile("s_waitcnt lgkmcnt(0)" ::: "memory");
#pragma unroll
        for (int cc = 0; cc < 2; ++cc) { const int n = lane >> 1, c = (lane & 1) * 2 + cc; const LAS float* sp = scr + (16 * c) * 33 + n;
            u32x4 w;
#pragma unroll
            for (int d = 0; d < 4; ++d) w[d] = pack_i8x4(sp[(4 * d) * 33], sp[(4 * d + 1) * 33], sp[(4 * d + 2) * 33], sp[(4 * d + 3) * 33]);
            *(u32x4*)(W8 + (size_t)(r0 + n) * K + k0 + 16 * c) = w; }
        asm volatile("s_waitcnt lgkmcnt(0)" ::: "memory");
    }
}
__device__ __forceinline__ int map_gu(int r) { const int pn = r >> 8, bj = (r >> 7) & 1, p = r & 127; return bj * DFF + pn * 128 + p; }
__device__ __forceinline__ int map_id(int r) { return r; }
__device__ __forceinline__ int map_win(int r) {
    if (r < 1536) return r;
    if (r < 2816) {
        const int pn = r >> 8, bj = (r >> 7) & 1, p = r & 127, hl = p >> 5, j = p & 31;
        if (pn == 6 || pn == 7) return SC_Q + (4 * (pn - 6) + hl) * 64 + bj * 32 + j;
        if (pn == 8) return hl < 2 ? SC_K + hl * 64 + bj * 32 + j : SC_V + (hl - 2) * 64 + bj * 32 + j;
        if (pn == 9) return SC_QI + hl * 64 + bj * 32 + j;
        if (hl == 0) return SC_KI + bj * 32 + j;
        if (hl == 1 && bj == 0) { if (j < 4) return SC_WI + j; if (j < 8) return SC_MI + (j - 4); if (j < 12) return SC_MF + (j - 8); }
        return -1;
    }
    if (r < 4864) return SC_MQ + (r - 2816);
    return SC_GT + (r - 4864);
}

__device__ __forceinline__ f32x4 ld_h4(const hres_t* row, int idx) { return __builtin_convertvector(((const h16x4*)row)[idx], f32x4); }
__device__ __forceinline__ void st_h4(hres_t* row, int idx, f32x4 v) { ((h16x4*)row)[idx] = __builtin_convertvector(v, h16x4); }
__device__ __forceinline__ unsigned pack_i8x4(float a, float b, float c, float d) {
    const int q0 = (int)__builtin_rintf(a), q1 = (int)__builtin_rintf(b), q2 = (int)__builtin_rintf(c), q3 = (int)__builtin_rintf(d);
    return ((unsigned)q0 & 255u) | (((unsigned)q1 & 255u) << 8) | (((unsigned)q2 & 255u) << 16) | ((unsigned)q3 << 24);
}
__device__ __forceinline__ void store_row_bf16(const f32x4 (&o)[4], bf16_t* urow, int lane) {
#pragma unroll
    for (int j = 0; j < 4; ++j) { u32x2 w; w.x = cvt_pk_bf16(o[j][0], o[j][1]); w.y = cvt_pk_bf16(o[j][2], o[j][3]); ((u32x2*)urow)[lane + 64 * j] = w; }
}
__device__ __forceinline__ void store_row_i8(const f32x4 (&o)[4], unsigned char* u8row, float* su_r, int lane) {
    float am = 0.f;
#pragma unroll
    for (int j = 0; j < 4; ++j) am = fmaxf(fmaxf(am, fmaxf(fabsf(o[j][0]), fabsf(o[j][1]))), fmaxf(fabsf(o[j][2]), fabsf(o[j][3])));
#pragma unroll
    for (int of = 1; of < 64; of <<= 1) am = fmaxf(am, __shfl_xor(am, of));
    const float inv = am > 0.f ? 127.0f / am : 0.f;
#pragma unroll
    for (int j = 0; j < 4; ++j) ((unsigned*)u8row)[lane + 64 * j] = pack_i8x4(o[j][0] * inv, o[j][1] * inv, o[j][2] * inv, o[j][3] * inv);
    if (lane == 0) *su_r = am * (1.0f / 127.0f);
}
__device__ __forceinline__ void norm_row(const bf16_t* yrow, const float* yf32  , int nz, hres_t* hrow, unsigned char* urow, float* su_r, bf16_t* ub  , const float* ga, const float* gb, float cscale, int lane) {
    asm volatile("" : "+v"(lane));
    const u32x2* yr = (const u32x2*)yrow + lane;
    f32x4 yv[4]; float ss = 0.f;
#pragma unroll
    for (int j = 0; j < 4; ++j) { if (yf32) { const f32x4* yp = (const f32x4*)yf32 + lane + 64 * j; f32x4 sl[11];
#pragma unroll
            for (int z = 0; z < 11; ++z) sl[z] = yp[(size_t)(z < nz ? z : 0) * 256 * DM / 4];
            f32x4 acc = sl[0];
#pragma unroll
            for (int z = 1; z < 11; ++z) acc += (z < nz) ? sl[z] : (f32x4){0.f, 0.f, 0.f, 0.f}; yv[j] = acc; } else { const u32x2 w = yr[64 * j]; yv[j] = (f32x4){bf_lo(w.x), bf_hi(w.x), bf_lo(w.y), bf_hi(w.y)}; } ss += (yv[j][0] * yv[j][0] + yv[j][1] * yv[j][1]) + (yv[j][2] * yv[j][2] + yv[j][3] * yv[j][3]); }
    const float rs = 1.0f / sqrtf(wave_sum(ss) * (1.0f / DM) + EPS);
    f32x4 hn[4]; float s2 = 0.f;
#pragma unroll
    for (int j = 0; j < 4; ++j) { const f32x4 g4 = ((const f32x4*)ga)[lane + 64 * j]; const h16x4 hh = __builtin_convertvector(ld_h4(hrow, lane + 64 * j) + cscale * (yv[j] * rs * g4), h16x4); ((h16x4*)hrow)[lane + 64 * j] = hh; hn[j] = __builtin_convertvector(hh, f32x4);
        s2 += (hn[j][0] * hn[j][0] + hn[j][1] * hn[j][1]) + (hn[j][2] * hn[j][2] + hn[j][3] * hn[j][3]); }
    const float rs2 = 1.0f / sqrtf(wave_sum(s2) * (1.0f / DM) + EPS);
    f32x4 ov[4];
#pragma unroll
    for (int j = 0; j < 4; ++j) { const f32x4 g4 = ((const f32x4*)gb)[lane + 64 * j]; ov[j] = hn[j] * rs2 * g4; }
    store_row_i8(ov, urow, su_r, lane);
    if (ub) store_row_bf16(ov, ub, lane);
}
__device__ __forceinline__ void norm_rows2(const bf16_t* y0, const bf16_t* y1, hres_t* h0, hres_t* h1, unsigned char* u0, unsigned char* u1, float* su0, float* su1, bf16_t* ub0, bf16_t* ub1  , bool has1, const float* ga, const float* gb, float cscale, int lane) {
    asm volatile("" : "+v"(lane));
    f32x4 yv[2][4], hv[2][4];
#pragma unroll
    for (int j = 0; j < 4; ++j) { const u32x2 w = ((const u32x2*)y0)[lane + 64 * j]; yv[0][j] = (f32x4){bf_lo(w.x), bf_hi(w.x), bf_lo(w.y), bf_hi(w.y)}; hv[0][j] = ld_h4(h0, lane + 64 * j); }
    if (has1) {
#pragma unroll
        for (int j = 0; j < 4; ++j) { const u32x2 w = ((const u32x2*)y1)[lane + 64 * j]; yv[1][j] = (f32x4){bf_lo(w.x), bf_hi(w.x), bf_lo(w.y), bf_hi(w.y)}; hv[1][j] = ld_h4(h1, lane + 64 * j); }
    } else {
#pragma unroll
        for (int j = 0; j < 4; ++j) { yv[1][j] = (f32x4){0.f, 0.f, 0.f, 0.f}; hv[1][j] = yv[1][j]; }
    }
    float ss0 = 0.f, ss1 = 0.f;
#pragma unroll
    for (int j = 0; j < 4; ++j) { ss0 += (yv[0][j][0] * yv[0][j][0] + yv[0][j][1] * yv[0][j][1]) + (yv[0][j][2] * yv[0][j][2] + yv[0][j][3] * yv[0][j][3]);
                                  ss1 += (yv[1][j][0] * yv[1][j][0] + yv[1][j][1] * yv[1][j][1]) + (yv[1][j][2] * yv[1][j][2] + yv[1][j][3] * yv[1][j][3]); }
#pragma unroll
    for (int o = 1; o < 64; o <<= 1) { ss0 += __shfl_xor(ss0, o); ss1 += __shfl_xor(ss1, o); }
    const float rs0 = 1.0f / sqrtf(ss0 * (1.0f / DM) + EPS), rs1 = 1.0f / sqrtf(ss1 * (1.0f / DM) + EPS);
    float s20 = 0.f, s21 = 0.f;
#pragma unroll
    for (int j = 0; j < 4; ++j) { const f32x4 g4 = ((const f32x4*)ga)[lane + 64 * j];
        const h16x4 hh0 = __builtin_convertvector(hv[0][j] + cscale * (yv[0][j] * rs0 * g4), h16x4), hh1 = __builtin_convertvector(hv[1][j] + cscale * (yv[1][j] * rs1 * g4), h16x4);
        ((h16x4*)h0)[lane + 64 * j] = hh0; if (has1) ((h16x4*)h1)[lane + 64 * j] = hh1;
        hv[0][j] = __builtin_convertvector(hh0, f32x4); hv[1][j] = __builtin_convertvector(hh1, f32x4);
        s20 += (hv[0][j][0] * hv[0][j][0] + hv[0][j][1] * hv[0][j][1]) + (hv[0][j][2] * hv[0][j][2] + hv[0][j][3] * hv[0][j][3]);
        s21 += (hv[1][j][0] * hv[1][j][0] + hv[1][j][1] * hv[1][j][1]) + (hv[1][j][2] * hv[1][j][2] + hv[1][j][3] * hv[1][j][3]); }
#pragma unroll
    for (int o = 1; o < 64; o <<= 1) { s20 += __shfl_xor(s20, o); s21 += __shfl_xor(s21, o); }
    const float r20 = 1.0f / sqrtf(s20 * (1.0f / DM) + EPS), r21 = 1.0f / sqrtf(s21 * (1.0f / DM) + EPS);
    f32x4 ov0[4], ov1[4];
#pragma unroll
    for (int j = 0; j < 4; ++j) { const f32x4 g4 = ((const f32x4*)gb)[lane + 64 * j]; ov0[j] = hv[0][j] * r20 * g4; ov1[j] = hv[1][j] * r21 * g4; }
    store_row_i8(ov0, u0, su0, lane);
    if (has1) store_row_i8(ov1, u1, su1, lane);
    if (ub0) { store_row_bf16(ov0, ub0, lane); if (has1) store_row_bf16(ov1, ub1, lane); }
}
__device__ __forceinline__ void nr_load(u32x2 (&yv)[2][4], h16x4 (&hv)[2][4], const bf16_t* Y, const hres_t* H, int r, int NGW, int lane) {
    const int r1 = r + NGW; const size_t o0 = (size_t)r * DM, o1 = (size_t)(r1 < MT ? r1 : r) * DM;
#pragma unroll
    for (int j = 0; j < 4; ++j) { yv[0][j] = ((const u32x2*)(Y + o0))[lane + 64 * j]; hv[0][j] = ((const h16x4*)(H + o0))[lane + 64 * j]; }
#pragma unroll
    for (int j = 0; j < 4; ++j) { yv[1][j] = ((const u32x2*)(Y + o1))[lane + 64 * j]; hv[1][j] = ((const h16x4*)(H + o1))[lane + 64 * j]; }
}
__device__ __forceinline__ unsigned pack_i8x4_magic(float a, float b, float c, float d, float inv) {
    const float MG = 12582912.0f;
    const unsigned qa = __float_as_uint(__builtin_fmaf(a, inv, MG)), qb = __float_as_uint(__builtin_fmaf(b, inv, MG)), qc = __float_as_uint(__builtin_fmaf(c, inv, MG)), qd = __float_as_uint(__builtin_fmaf(d, inv, MG));
    const unsigned ab = __builtin_amdgcn_perm(qb, qa, 0x0c0c0400u), cd = __builtin_amdgcn_perm(qd, qc, 0x0c0c0400u);
    return __builtin_amdgcn_perm(cd, ab, 0x05040100u);
}
__device__ __forceinline__ void nr_finish(const u32x2 (&yr)[2][4], const h16x4 (&hr)[2][4], hres_t* H, unsigned char* U8, float* SU, bf16_t* UB, const f32x4 (&gA)[4], const f32x4 (&gB)[4], float cscale, int r, int NGW, int lane) {
    const int r1 = r + NGW; const bool has1 = r1 < MT; const size_t o[2] = {(size_t)r * DM, (size_t)(has1 ? r1 : r) * DM};
    f32x4 yv[2][4]; float ss[2] = {0.f, 0.f};
#pragma unroll
    for (int q = 0; q < 2; ++q)
#pragma unroll
        for (int j = 0; j < 4; ++j) { const u32x2 w = yr[q][j]; yv[q][j] = (f32x4){bf_lo(w.x), bf_hi(w.x), bf_lo(w.y), bf_hi(w.y)};
            ss[q] += (yv[q][j][0] * yv[q][j][0] + yv[q][j][1] * yv[q][j][1]) + (yv[q][j][2] * yv[q][j][2] + yv[q][j][3] * yv[q][j][3]); }
#pragma unroll
    for (int of = 1; of < 64; of <<= 1) { ss[0] += __shfl_xor(ss[0], of); ss[1] += __shfl_xor(ss[1], of); }
    const float rs[2] = {cscale * __builtin_amdgcn_rsqf(ss[0] * (1.0f / DM) + EPS), cscale * __builtin_amdgcn_rsqf(ss[1] * (1.0f / DM) + EPS)};
    f32x4 hv[2][4]; float s2[2] = {0.f, 0.f};
#pragma unroll
    for (int j = 0; j < 4; ++j) { const f32x4 g4 = gA[j];
#pragma unroll
        for (int q = 0; q < 2; ++q) { const h16x4 hh = __builtin_convertvector(__builtin_convertvector(hr[q][j], f32x4) + (yv[q][j] * g4) * rs[q], h16x4);
            if (q == 0 || has1) ((h16x4*)(H + o[q]))[lane + 64 * j] = hh;
            hv[q][j] = __builtin_convertvector(hh, f32x4);
            s2[q] += (hv[q][j][0] * hv[q][j][0] + hv[q][j][1] * hv[q][j][1]) + (hv[q][j][2] * hv[q][j][2] + hv[q][j][3] * hv[q][j][3]); } }
#pragma unroll
    for (int of = 1; of < 64; of <<= 1) { s2[0] += __shfl_xor(s2[0], of); s2[1] += __shfl_xor(s2[1], of); }
    const float r2[2] = {__builtin_amdgcn_rsqf(s2[0] * (1.0f / DM) + EPS), __builtin_amdgcn_rsqf(s2[1] * (1.0f / DM) + EPS)};
    float am[2] = {0.f, 0.f};
#pragma unroll
    for (int j = 0; j < 4; ++j) { const f32x4 g4 = gB[j];
#pragma unroll
        for (int q = 0; q < 2; ++q) { hv[q][j] = (hv[q][j] * g4) * r2[q];
            am[q] = fmaxf(fmaxf(am[q], fmaxf(fabsf(hv[q][j][0]), fabsf(hv[q][j][1]))), fmaxf(fabsf(hv[q][j][2]), fabsf(hv[q][j][3]))); } }
#pragma unroll
    for (int of = 1; of < 64; of <<= 1) { am[0] = fmaxf(am[0], __shfl_xor(am[0], of)); am[1] = fmaxf(am[1], __shfl_xor(am[1], of)); }
#pragma unroll
    for (int q = 0; q < 2; ++q) {
        if (q == 1 && !has1) break;
        const float inv = am[q] > 0.f ? 127.0f * __builtin_amdgcn_rcpf(am[q]) : 0.f;
#pragma unroll
        for (int j = 0; j < 4; ++j) ((unsigned*)(U8 + o[q]))[lane + 64 * j] = pack_i8x4_magic(hv[q][j][0], hv[q][j][1], hv[q][j][2], hv[q][j][3], inv);
        if (lane == 0) SU[q ? r1 : r] = am[q] * (1.0f / 127.0f);
        if (UB) {
#pragma unroll
            for (int j = 0; j < 4; ++j) { u32x2 w; w.x = cvt_pk_bf16(hv[q][j][0], hv[q][j][1]); w.y = cvt_pk_bf16(hv[q][j][2], hv[q][j][3]); ((u32x2*)(UB + o[q]))[lane + 64 * j] = w; }
        }
    }
}
__device__ __forceinline__ void norm_pass(const bf16_t* Y, hres_t* H, unsigned char* U8, float* SU, bf16_t* UB  , const float* ga, const float* gb, float cscale, int gw, int NGW, int lane) {
    asm volatile("" : "+v"(lane));
    u32x2 yA[2][4], yB[2][4]; h16x4 hA[2][4], hB[2][4];
    f32x4 gA[4], gB[4];
#pragma unroll
    for (int j = 0; j < 4; ++j) { gA[j] = ((const f32x4*)ga)[lane + 64 * j]; gB[j] = ((const f32x4*)gb)[lane + 64 * j]; }
    int r = gw;
    if (r >= MT) return;
    nr_load(yA, hA, Y, H, r, NGW, lane);
#pragma unroll 1
    for (;;) {
        const int rn = r + 2 * NGW;
        nr_load(yB, hB, Y, H, rn < MT ? rn : r, NGW, lane);
        nr_finish(yA, hA, H, U8, SU, UB, gA, gB, cscale, r, NGW, lane);
        if (rn >= MT) break;
        r = rn + 2 * NGW;
        nr_load(yA, hA, Y, H, r < MT ? r : rn, NGW, lane);
        nr_finish(yB, hB, H, U8, SU, UB, gA, gB, cscale, rn, NGW, lane);
        if (r >= MT) break;
    }
}
__device__ __forceinline__ void init_load(f32x4 (&sv)[2][4], const float* x, const float* meta, int r, int NGW, int lane) {
#pragma unroll
    for (int q = 0; q < 2; ++q) { int rr = r + q * NGW; rr = rr < M ? rr : r; const int b = rr / T, t = rr - b * T;
        const float* src = t < NMETA ? meta + (size_t)t * DM : x + ((size_t)b * SEQ + (t - NMETA)) * DM;
#pragma unroll
        for (int j = 0; j < 4; ++j) sv[q][j] = ((const f32x4*)src)[lane + 64 * j]; }
}
__device__ __forceinline__ void init_finish(const f32x4 (&sv)[2][4], hres_t* H, unsigned char* U8, float* SU, const f32x4 (&gB)[4], int r, int NGW, int lane) {
    const int r1 = r + NGW; const bool has1 = r1 < M; const size_t o[2] = {(size_t)r * DM, (size_t)(has1 ? r1 : r) * DM};
    f32x4 hv[2][4]; float s2[2] = {0.f, 0.f};
#pragma unroll
    for (int q = 0; q < 2; ++q)
#pragma unroll
        for (int j = 0; j < 4; ++j) { const h16x4 hh = __builtin_convertvector(sv[q][j], h16x4); if (q == 0 || has1) ((h16x4*)(H + o[q]))[lane + 64 * j] = hh; hv[q][j] = __builtin_convertvector(hh, f32x4);
            s2[q] += (hv[q][j][0] * hv[q][j][0] + hv[q][j][1] * hv[q][j][1]) + (hv[q][j][2] * hv[q][j][2] + hv[q][j][3] * hv[q][j][3]); }
#pragma unroll
    for (int of = 1; of < 64; of <<= 1) { s2[0] += __shfl_xor(s2[0], of); s2[1] += __shfl_xor(s2[1], of); }
    const float r2[2] = {__builtin_amdgcn_rsqf(s2[0] * (1.0f / DM) + EPS), __builtin_amdgcn_rsqf(s2[1] * (1.0f / DM) + EPS)};
    float am[2] = {0.f, 0.f};
#pragma unroll
    for (int j = 0; j < 4; ++j)
#pragma unroll
        for (int q = 0; q < 2; ++q) { hv[q][j] = (hv[q][j] * gB[j]) * r2[q];
            am[q] = fmaxf(fmaxf(am[q], fmaxf(fabsf(hv[q][j][0]), fabsf(hv[q][j][1]))), fmaxf(fabsf(hv[q][j][2]), fabsf(hv[q][j][3]))); }
#pragma unroll
    for (int of = 1; of < 64; of <<= 1) { am[0] = fmaxf(am[0], __shfl_xor(am[0], of)); am[1] = fmaxf(am[1], __shfl_xor(am[1], of)); }
#pragma unroll
    for (int q = 0; q < 2; ++q) {
        if (q == 1 && !has1) break;
        const float inv = am[q] > 0.f ? 127.0f * __builtin_amdgcn_rcpf(am[q]) : 0.f;
#pragma unroll
        for (int j = 0; j < 4; ++j) ((unsigned*)(U8 + o[q]))[lane + 64 * j] = pack_i8x4_magic(hv[q][j][0], hv[q][j][1], hv[q][j][2], hv[q][j][3], inv);
        if (lane == 0) SU[q ? r1 : r] = am[q] * (1.0f / 127.0f);
    }
}
__device__ __forceinline__ void init_pass(const float* x, const float* meta, hres_t* H, unsigned char* U8, float* SU, const float* gb, int gw, int NGW, int lane) {
    asm volatile("" : "+v"(lane));
    f32x4 sA[2][4], sB[2][4], gB[4];
#pragma unroll
    for (int j = 0; j < 4; ++j) gB[j] = ((const f32x4*)gb)[lane + 64 * j];
    int r = gw;
    if (r >= M) return;
    init_load(sA, x, meta, r, NGW, lane);
#pragma unroll 1
    for (;;) {
        const int rn = r + 2 * NGW;
        init_load(sB, x, meta, rn < M ? rn : r, NGW, lane);
        init_finish(sA, H, U8, SU, gB, r, NGW, lane);
        if (rn >= M) break;
        r = rn + 2 * NGW;
        init_load(sA, x, meta, r < M ? r : rn, NGW, lane);
        init_finish(sB, H, U8, SU, gB, rn, NGW, lane);
        if (r >= M) break;
    }
}
__device__ __forceinline__ void init_row(const float* src, hres_t* hrow, unsigned char* urow, float* su_r, const float* gb, int lane) {
    asm volatile("" : "+v"(lane));
    const f32x4* sr = (const f32x4*)src + lane;
    f32x4 hn[4]; float s2 = 0.f;
#pragma unroll
    for (int j = 0; j < 4; ++j) { const h16x4 hh = __builtin_convertvector(sr[64 * j], h16x4); ((h16x4*)hrow)[lane + 64 * j] = hh; hn[j] = __builtin_convertvector(hh, f32x4); s2 += (hn[j][0] * hn[j][0] + hn[j][1] * hn[j][1]) + (hn[j][2] * hn[j][2] + hn[j][3] * hn[j][3]); }
    const float rs2 = 1.0f / sqrtf(wave_sum(s2) * (1.0f / DM) + EPS);
    f32x4 ov[4];
#pragma unroll
    for (int j = 0; j < 4; ++j) { const f32x4 g4 = ((const f32x4*)gb)[lane + 64 * j]; ov[j] = hn[j] * rs2 * g4; }
    store_row_i8(ov, urow, su_r, lane);
}

#define DPP_STEP_U(v, ctrl, rmask) ((unsigned)__builtin_amdgcn_update_dpp(0, (int)(v), ctrl, rmask, 0xf, false))
#define DPP_STEP_F(v, ctrl, rmask) __int_as_float(__builtin_amdgcn_update_dpp(0, __float_as_int(v), ctrl, rmask, 0xf, false))
#define DPP_STEP_M(v, ctrl, rmask) __int_as_float(__builtin_amdgcn_update_dpp((int)0xff800000, __float_as_int(v), ctrl, rmask, 0xf, false))
__device__ __forceinline__ unsigned wave_incl_sum_u(unsigned v, int) {
    v += DPP_STEP_U(v, 0x111, 0xf); v += DPP_STEP_U(v, 0x112, 0xf); v += DPP_STEP_U(v, 0x114, 0xf); v += DPP_STEP_U(v, 0x118, 0xf);
    v += DPP_STEP_U(v, 0x142, 0xa); v += DPP_STEP_U(v, 0x143, 0xc);
    return v;
}
__device__ __forceinline__ float wave_incl_sum(float v, int) {
    v += DPP_STEP_F(v, 0x111, 0xf); v += DPP_STEP_F(v, 0x112, 0xf); v += DPP_STEP_F(v, 0x114, 0xf); v += DPP_STEP_F(v, 0x118, 0xf);
    v += DPP_STEP_F(v, 0x142, 0xa); v += DPP_STEP_F(v, 0x143, 0xc);
    return v;
}
__device__ __forceinline__ float wave_incl_max(float v, int) {
    v = fmaxf(v, DPP_STEP_M(v, 0x111, 0xf)); v = fmaxf(v, DPP_STEP_M(v, 0x112, 0xf)); v = fmaxf(v, DPP_STEP_M(v, 0x114, 0xf)); v = fmaxf(v, DPP_STEP_M(v, 0x118, 0xf));
    v = fmaxf(v, DPP_STEP_M(v, 0x142, 0xa)); v = fmaxf(v, DPP_STEP_M(v, 0x143, 0xc));
    return v;
}
__device__ __forceinline__ float wave_max(float v) {
#pragma unroll
    for (int o = 1; o < 64; o <<= 1) v = fmaxf(v, __shfl_xor(v, o));
    return v;
}
__device__ __forceinline__ unsigned keep_low(unsigned x, unsigned n) { unsigned cnt = __popc(x); while (cnt > n) { x &= ~(0x80000000u >> __clz(x)); --cnt; } return x; }
#define LDSW() asm volatile("s_waitcnt lgkmcnt(0)" ::: "memory")

__device__ __forceinline__ void conv_item(const bf16_t* P, bf16_t* YB, const float* wconv  , int bl, int ci, int tid) {
    asm volatile("" : "+v"(tid));
    const int ch = (tid & 63) * 8;
    const f32x4 w0a = *(const f32x4*)(wconv + ch), w0b = *(const f32x4*)(wconv + ch + 4), w1a = *(const f32x4*)(wconv + 512 + ch), w1b = *(const f32x4*)(wconv + 512 + ch + 4),
                w2a = *(const f32x4*)(wconv + 1024 + ch), w2b = *(const f32x4*)(wconv + 1024 + ch + 4);
#pragma unroll 1
    for (int i0 = 0; i0 < 16; i0 += 4) {
        u32x4 xb[4], x0[4], c0[4], x1[4], c1[4], x2[4], c2[4]; int tt[4];
#pragma unroll
        for (int u = 0; u < 4; ++u) { const int t = 128 * ci + 8 * (i0 + u) + (tid >> 6); tt[u] = t; const int tc = t < T ? t : T - 1;
            const bf16_t* row = P + (size_t)(bl * T + tc) * LDP;
            xb[u] = *(const u32x4*)(row + PC_CB + ch); x0[u] = *(const u32x4*)(row + PC_CX + ch); c0[u] = *(const u32x4*)(row + PC_CC + ch);
            const bf16_t* r1 = tc >= 1 ? row - LDP : row; const bf16_t* r2 = tc >= 2 ? row - 2 * LDP : row;
            x1[u] = *(const u32x4*)(r1 + PC_CX + ch); c1[u] = *(const u32x4*)(r1 + PC_CC + ch); x2[u] = *(const u32x4*)(r2 + PC_CX + ch); c2[u] = *(const u32x4*)(r2 + PC_CC + ch); }
#pragma unroll
        for (int u = 0; u < 4; ++u) { const int t = tt[u];
            float o[8];
#pragma unroll
            for (int j = 0; j < 8; ++j) { const int d = j >> 1; const bool hi = j & 1;
                const float u0 = (hi ? bf_hi(x0[u][d]) : bf_lo(x0[u][d])) * (hi ? bf_hi(c0[u][d]) : bf_lo(c0[u][d]));
                const float u1 = t >= 1 ? (hi ? bf_hi(x1[u][d]) : bf_lo(x1[u][d])) * (hi ? bf_hi(c1[u][d]) : bf_lo(c1[u][d])) : 0.f;
                const float u2 = t >= 2 ? (hi ? bf_hi(x2[u][d]) : bf_lo(x2[u][d])) * (hi ? bf_hi(c2[u][d]) : bf_lo(c2[u][d])) : 0.f;
                const float w0 = j < 4 ? w0a[j] : w0b[j - 4], w1 = j < 4 ? w1a[j] : w1b[j - 4], w2 = j < 4 ? w2a[j] : w2b[j - 4];
                const float cbv = hi ? bf_hi(xb[u][d]) : bf_lo(xb[u][d]);
                o[j] = cbv * (w0 * u2 + w1 * u1 + w2 * u0); }
            u32x4 w; w.x = cvt_pk_bf16(o[0], o[1]); w.y = cvt_pk_bf16(o[2], o[3]); w.z = cvt_pk_bf16(o[4], o[5]); w.w = cvt_pk_bf16(o[6], o[7]);
            if (t < T) *(u32x4*)(YB + (size_t)(bl * T + t) * LDY + ch) = w; }
    }
}

constexpr int SA_HIST = 0, SA_GT = 16384, SA_EQ = 24832, SA_SEL = 33280  , SA_MM = 33792  , SA_FSEL = 36864  , SA_LISTS = 36864  , SA_SPS = 53248  , DENSE_QB = 128, SA_SP = 53248  , SA_CAND = SA_SP, SA_CAP = 512;
#ifndef PROBE_ID
#define PROBE_ID 0
#endif
#define SEC_T0(k) unsigned long long st0_##k = 0; if ((PROBE_ID >> (k)) & 1) st0_##k = __builtin_amdgcn_s_memrealtime();
#define SEC_T1(k) if ((PROBE_ID >> (k)) & 1) { const unsigned long long t1_ = __builtin_amdgcn_s_memrealtime(); const unsigned long long d_ = t1_ - st0_##k; while (__builtin_amdgcn_s_memrealtime() - t1_ < d_) __builtin_amdgcn_s_sleep(4); }
__device__ __forceinline__ unsigned f2key(float f) { const unsigned b = __float_as_uint(f); return b ^ ((unsigned)((int)b >> 31) | 0x80000000u); }
__device__ __forceinline__ float key2f(unsigned k) { return __uint_as_float(k ^ ((k >> 31) ? 0x80000000u : 0xFFFFFFFFu)); }
__device__ __forceinline__ void selattn_item(LAS unsigned char* lds, const bf16_t* P, bf16_t* YB, const bf16_t* KV, const bf16_t* KI, int bl, int qb, int tid, int lane, int wave) {
    asm volatile("" : "+v"(tid)); lane = tid & 63;
    const int t0 = qb * 16, nkt = qb + 1; const size_t rowbase = (size_t)bl * T;
    const int c16 = lane & 15, g4 = lane >> 4;
    LAS unsigned* hist = (LAS unsigned*)(lds + SA_HIST);
    LAS unsigned* selp = (LAS unsigned*)(lds + SA_SEL);
    LAS float* smm = (LAS float*)(lds + SA_MM);
    const bool selall = (qb < 16);
    const float NINF = -__builtin_inff();
    for (int i = tid; i < 2 * 16 * 132; i += 512) ((LAS unsigned*)(lds + SA_GT))[i] = 0u;
    for (int i = tid; i < 4096; i += 512) hist[i] = 0u;
    if (tid < 80) selp[tid] = 0u;
    SEC_T0(12)
    bf16x8 aq[4][2];
    { const bf16_t* qrow = P + (rowbase + t0 + c16) * LDP + PC_QI + g4 * 8;
#pragma unroll
      for (int h = 0; h < 4; ++h)
#pragma unroll
          for (int ks = 0; ks < 2; ++ks) aq[h][ks] = *(const bf16x8*)(qrow + h * 64 + ks * 32); }
    LAS float* wqw = (LAS float*)(lds + SA_FSEL + wave * 256);
    wqw[lane] = bf2f(P[(rowbase + t0 + (lane >> 2)) * LDP + PC_WI + (lane & 3)]) * 0.0625f;
    float sc[33][4]; float mx[4], mn[4];
#pragma unroll
    for (int r = 0; r < 4; ++r) { mx[r] = NINF; mn[r] = __builtin_inff(); }
#pragma unroll
    for (int s = 0; s < 33; ++s) { sc[s][0] = NINF; sc[s][1] = NINF; sc[s][2] = NINF; sc[s][3] = NINF; }
    const int ns = (nkt - wave + 7) >> 3;
    LDSW();
    bf16x8 kb[3][2];
#define S1_LOAD(bi_, s_) do { const int kt_ = wave + 8 * (s_); const int ktc_ = kt_ < nkt ? kt_ : nkt - 1; \
        const bf16_t* kr_ = KI + (rowbase + ktc_ * 16 + c16) * 64 + g4 * 8; kb[bi_][0] = *(const bf16x8*)kr_; kb[bi_][1] = *(const bf16x8*)(kr_ + 32); } while (0)
#define S1_COMP(bi_, s_) do { const int s = (s_); const int kt = wave + 8 * s; f32x4 ac[4]; \
        _Pragma("unroll") for (int h = 0; h < 4; ++h) { ac[h] = __builtin_amdgcn_mfma_f32_16x16x32_bf16(aq[h][0], kb[bi_][0], (f32x4){0.f, 0.f, 0.f, 0.f}, 0, 0, 0); ac[h] = __builtin_amdgcn_mfma_f32_16x16x32_bf16(aq[h][1], kb[bi_][1], ac[h], 0, 0, 0); } \
        _Pragma("unroll") for (int r = 0; r < 4; ++r) { const f32x4 wr_ = *(const LAS f32x4*)(wqw + (4 * g4 + r) * 4); \
            float sv = wr_[0] * fmaxf(ac[0][r], 0.f); \
            sv = __builtin_fmaf(wr_[1], fmaxf(ac[1][r], 0.f), sv); sv = __builtin_fmaf(wr_[2], fmaxf(ac[2][r], 0.f), sv); sv = __builtin_fmaf(wr_[3], fmaxf(ac[3][r], 0.f), sv); \
            sv = (sv == 0.f) ? 0.f : sv;                                                               \
            const bool valid = (kt * 16 + c16 <= t0 + 4 * g4 + r);                                    \
            sc[s][r] = valid ? sv : NINF; mx[r] = fmaxf(mx[r], sc[s][r]); mn[r] = fminf(mn[r], valid ? sv : __builtin_inff()); } } while (0)
#define S1_LVL(k_) if ((k_) < ns) { if ((k_) + 2 < 33) S1_LOAD(((k_) + 2) % 3, (k_) + 2); asm volatile("" ::: "memory");     \
        S1_COMP((k_) % 3, (k_));
    S1_LOAD(0, 0); S1_LOAD(1, 1); asm volatile("" ::: "memory");
    S1_LVL(0) S1_LVL(1) S1_LVL(2) S1_LVL(3) S1_LVL(4) S1_LVL(5) S1_LVL(6) S1_LVL(7) S1_LVL(8) S1_LVL(9) S1_LVL(10) S1_LVL(11) S1_LVL(12) S1_LVL(13) S1_LVL(14) S1_LVL(15) S1_LVL(16) S1_LVL(17) S1_LVL(18) S1_LVL(19) S1_LVL(20) S1_LVL(21) S1_LVL(22) S1_LVL(23) S1_LVL(24) S1_LVL(25) S1_LVL(26) S1_LVL(27) S1_LVL(28) S1_LVL(29) S1_LVL(30) S1_LVL(31) S1_LVL(32)
    } } } } } } } } } } } } } } } } } } } } } } } } } } } } } } } } }
#undef S1_LVL
#undef S1_LOAD
#undef S1_COMP
    SEC_T1(12)
    SEC_T0(13)
    if (!selall) {
#pragma unroll
        for (int r = 0; r < 4; ++r) {
#pragma unroll
            for (int o = 1; o < 16; o <<= 1) { mx[r] = fmaxf(mx[r], __shfl_xor(mx[r], o)); mn[r] = fminf(mn[r], __shfl_xor(mn[r], o)); }
            if (c16 == 0) { smm[(wave * 16 + 4 * g4 + r) * 2] = mx[r]; smm[(wave * 16 + 4 * g4 + r) * 2 + 1] = mn[r]; } }
        __syncthreads();
        if (tid < 16) { float hi = NINF, lo = __builtin_inff();
#pragma unroll
            for (int w8 = 0; w8 < 8; ++w8) { hi = fmaxf(hi, smm[(w8 * 16 + tid) * 2]); lo = fminf(lo, smm[(w8 * 16 + tid) * 2 + 1]); }
            const float scl = hi > lo ? 255.99f / (hi - lo) : 0.f; smm[256 + 2 * tid] = scl; smm[256 + 2 * tid + 1] = -lo * scl; }
        __syncthreads();
        float bsc[4], bof[4];
#pragma unroll
        for (int r = 0; r < 4; ++r) { bsc[r] = smm[256 + 2 * (4 * g4 + r)]; bof[r] = smm[256 + 2 * (4 * g4 + r) + 1]; }
#pragma unroll
        for (int s = 0; s < 33; ++s) if (s < ns) {
#pragma unroll
            for (int r = 0; r < 4; ++r) { unsigned bin = (unsigned)__builtin_fmaf(sc[s][r], bsc[r], bof[r]); bin = bin > 255u ? 255u : bin;
                __hip_atomic_fetch_add(&hist[(4 * g4 + r) * 256 + bin], 1u, __ATOMIC_RELAXED, __HIP_MEMORY_SCOPE_WORKGROUP); } }
        __syncthreads();
#pragma unroll
        for (int qq = 0; qq < 2; ++qq) { const int q = 2 * wave + qq;
            u32x4 cnt = *(const LAS u32x4*)&hist[q * 256 + 252 - 4 * lane];
            if (lane == 63) cnt.x -= (unsigned)(15 - q);
            const unsigned tot = cnt.x + cnt.y + cnt.z + cnt.w;
            const unsigned inc = wave_incl_sum_u(tot, lane), exc = inc - tot;
            if (exc < 256u && 256u <= inc) {
                unsigned cum = exc; int d;
                if (256u <= cum + cnt.w) d = 255 - 4 * lane; else { cum += cnt.w; if (256u <= cum + cnt.z) d = 254 - 4 * lane; else { cum += cnt.z; if (256u <= cum + cnt.y) d = 253 - 4 * lane; else { cum += cnt.y; d = 252 - 4 * lane; } } }
                selp[32 + q] = (unsigned)d; selp[16 + q] = 256u - cum;
            }
        }
        __syncthreads();
        {
            unsigned bst[4];
#pragma unroll
            for (int r = 0; r < 4; ++r) { bst[r] = selp[32 + 4 * g4 + r]; asm volatile("" : "+v"(bsc[r]), "+v"(bof[r])); }
            LAS unsigned* cand = (LAS unsigned*)(lds + SA_CAND);
#pragma unroll
            for (int s = 0; s < 33; ++s) if (s < ns) {
#pragma unroll
                for (int r = 0; r < 4; ++r) { unsigned bin = (unsigned)__builtin_fmaf(sc[s][r], bsc[r], bof[r]); bin = bin > 255u ? 255u : bin;
                    if (bin == bst[r] && sc[s][r] > NINF) { const unsigned pos = __hip_atomic_fetch_add(&selp[48 + 4 * g4 + r], 1u, __ATOMIC_RELAXED, __HIP_MEMORY_SCOPE_WORKGROUP);
                        if (pos < (unsigned)SA_CAP) cand[(4 * g4 + r) * SA_CAP + pos] = f2key(sc[s][r]); } } }
        }
        __syncthreads();
#pragma unroll 1
        for (int qq = 0; qq < 2; ++qq) { const int q = 2 * wave + qq;
            const unsigned m = selp[48 + q], need = selp[16 + q];
            if (m > (unsigned)SA_CAP || FORCE_FALLBACK) { if (lane == 0) selp[64] = 1u; continue; }
            const LAS unsigned* cand = (const LAS unsigned*)(lds + SA_CAND) + q * SA_CAP;
            if (m <= 64u) {
                const unsigned myk = (unsigned)lane < m ? cand[lane] : 0u;
                unsigned cgt = 0u, cge = 0u;
#pragma unroll 1
                for (unsigned j = 0; j < m; ++j) { const unsigned kj = (unsigned)__builtin_amdgcn_readlane((int)myk, (int)j); cgt += (kj > myk) ? 1u : 0u; cge += (kj >= myk) ? 1u : 0u; }
                const unsigned long long hit = __ballot((unsigned)lane < m && cgt < need && need <= cge);
                const int L = (int)__ffsll((long long)hit) - 1;
                const unsigned tk = (unsigned)__builtin_amdgcn_readlane((int)myk, L), tg = (unsigned)__builtin_amdgcn_readlane((int)cgt, L);
                if (lane == 0) { selp[q] = __float_as_uint(key2f(tk)); selp[16 + q] = need - tg; }
                continue;
            }
            unsigned ck[8];
#pragma unroll
            for (int i = 0; i < 8; ++i) ck[i] = (unsigned)(lane + 64 * i) < m ? cand[lane + 64 * i] : 0u;
            const int nreg = (int)((m + 63u) >> 6);
            unsigned trial = 0u;
#pragma unroll 1
            for (int bit = 31; bit >= 0; --bit) { const unsigned t = trial | (1u << bit); unsigned cntv = (unsigned)__popcll(__ballot(ck[0] >= t));
                if (nreg > 1) {
#pragma unroll
                    for (int i = 1; i < 8; ++i) cntv += (unsigned)__popcll(__ballot(ck[i] >= t)); }
                if (cntv >= need) trial = t; }
            unsigned cgt = 0u;
#pragma unroll
            for (int i = 0; i < 8; ++i) cgt += (unsigned)__popcll(__ballot(ck[i] > trial));
            if (lane == 0) { selp[q] = __float_as_uint(key2f(trial)); selp[16 + q] = need - cgt; }
        }
        __syncthreads();
        if (selp[64] != 0u) {
            if (tid < 16) { selp[tid] = 0u; selp[16 + tid] = 256u; }
#pragma unroll 1
            for (int p = 0; p < 4; ++p) {
                const int shift = 24 - 8 * p; const unsigned hmask = (p == 0) ? 0u : (0xFFFFFFFFu << (shift + 8));
                __syncthreads();
                for (int i = tid; i < 4096; i += 512) hist[i] = 0u;
                __syncthreads();
                unsigned pf[4]; unsigned zero = 0u; asm volatile("" : "+v"(zero));
#pragma unroll
                for (int r = 0; r < 4; ++r) pf[r] = selp[4 * g4 + r];
#pragma unroll
                for (int s = 0; s < 33; ++s)
#pragma unroll
                    for (int r = 0; r < 4; ++r) { const unsigned key = f2key(__uint_as_float(__float_as_uint(sc[s][r]) | zero));
                        if (sc[s][r] > NINF && ((key ^ pf[r]) & hmask) == 0u) __hip_atomic_fetch_add(&hist[(4 * g4 + r) * 256 + ((key >> shift) & 255u)], 1u, __ATOMIC_RELAXED, __HIP_MEMORY_SCOPE_WORKGROUP); }
                __syncthreads();
#pragma unroll
                for (int qq = 0; qq < 2; ++qq) { const int q = 2 * wave + qq;
                    const u32x4 cnt = *(const LAS u32x4*)&hist[q * 256 + 252 - 4 * lane];
                    const unsigned tot = cnt.x + cnt.y + cnt.z + cnt.w;
                    const unsigned inc = wave_incl_sum_u(tot, lane), exc = inc - tot;
                    const unsigned krem = selp[16 + q];
                    if (exc < krem && krem <= inc) {
                        unsigned cum = exc; int d;
                        if (krem <= cum + cnt.w) d = 255 - 4 * lane; else { cum += cnt.w; if (krem <= cum + cnt.z) d = 254 - 4 * lane; else { cum += cnt.z; if (krem <= cum + cnt.y) d = 253 - 4 * lane; else { cum += cnt.y; d = 252 - 4 * lane; } } }
                        selp[q] = selp[q] | ((unsigned)d << shift); selp[16 + q] = krem - cum;
                    }
                }
            }
            __syncthreads();
            if (tid < 16) selp[tid] = __float_as_uint(key2f(selp[tid]));
            __syncthreads();
        }
    } else __syncthreads();
    SEC_T1(13)
    SEC_T0(14)
    {
        int nkt3 = nkt; asm volatile("" : "+s"(nkt3));
        float tau[4];
#pragma unroll
        for (int r = 0; r < 4; ++r) tau[r] = selall ? NINF : __uint_as_float(selp[4 * g4 + r]);
        LAS unsigned long long* bg64 = (LAS unsigned long long*)(lds + SA_GT); LAS unsigned long long* be64 = (LAS unsigned long long*)(lds + SA_EQ);
#pragma unroll
        for (int s = 0; s < 33; ++s) {
            const int kt = wave + 8 * s;
            if (kt < nkt3) {
#pragma unroll
                for (int r = 0; r < 4; ++r) { const float x = sc[s][r]; const bool g = x > tau[r]; const bool e = (!selall) && (x == tau[r]);
                    const unsigned long long vg = __ballot(g), ve = __ballot(e);
                    if (lane == 0) { bg64[kt * 4 + r] = vg; be64[kt * 4 + r] = ve; } }
            }
            __builtin_amdgcn_sched_barrier(0);
        }
    }
    __syncthreads();
    SEC_T1(14)
    SEC_T0(15)
    if (qb < DENSE_QB) {
    SEC_T0(23)
    LAS unsigned* fsel = (LAS unsigned*)(lds + SA_FSEL);
#pragma unroll
    for (int qq = 0; qq < 2; ++qq) {
        const int q = 2 * wave + qq;
        const LAS unsigned short* hgt = (const LAS unsigned short*)(lds + SA_GT) + (q & 3) * 4 + (q >> 2); const LAS unsigned short* heq = (const LAS unsigned short*)(lds + SA_EQ) + (q & 3) * 4 + (q >> 2);
#define SA_WORD(hp, j) ((unsigned)(hp)[(2 * (j)) * 16] | ((unsigned)(hp)[(2 * (j) + 1) * 16] << 16))
        unsigned g0 = SA_WORD(hgt, lane), g1 = SA_WORD(hgt, lane + 64), g2 = lane < 4 ? SA_WORD(hgt, lane + 128) : 0u;
        unsigned e0 = SA_WORD(heq, lane), e1 = SA_WORD(heq, lane + 64), e2 = lane < 4 ? SA_WORD(heq, lane + 128) : 0u;
#undef SA_WORD
        const unsigned krem = selall ? 0u : selp[16 + q];
        {
            const unsigned c0 = __popc(e0), c1 = __popc(e1), c2 = __popc(e2);
            const unsigned i0 = wave_incl_sum_u(c0, lane), i1 = wave_incl_sum_u(c1, lane), i2 = wave_incl_sum_u(c2, lane);
            const unsigned T0 = __shfl(i0, 63), T1 = __shfl(i1, 63);
            const unsigned x0 = i0 - c0, x1 = T0 + i1 - c1, x2 = T0 + T1 + i2 - c2;
            e0 = keep_low(e0, krem > x0 ? krem - x0 : 0u); e1 = keep_low(e1, krem > x1 ? krem - x1 : 0u); e2 = keep_low(e2, krem > x2 ? krem - x2 : 0u);
        }
        fsel[q * 132 + lane] = g0 | e0; fsel[q * 132 + lane + 64] = g1 | e1; if (lane < 4) fsel[q * 132 + lane + 128] = g2 | e2;
    }
    LDSW();
    {
        const int g = wave & 1, qquad = wave >> 1, qi = 4 * qquad + (c16 >> 2), hq = 4 * g + (c16 & 3);
        const int nsteps = (t0 + 16 + 63) >> 6;
        const char* kvb = (const char*)(KV + rowbase * 256);
        LAS unsigned char* tile0 = lds + SA_SP; LAS unsigned char* tile1 = lds + SA_SP + 64 * 528;
        const int srow = tid >> 5, schk = tid & 31;
        u32x4 pre[4];
#define DA_LOAD(st_) do { _Pragma("unroll") for (int k2 = 0; k2 < 4; ++k2) { int key_ = 64 * (st_) + srow + 16 * k2; key_ = key_ < T ? key_ : T - 1; pre[k2] = *(const u32x4*)(kvb + (size_t)key_ * 512 + schk * 16); } } while (0)
#define DA_STORE(tl_) do { _Pragma("unroll") for (int k2 = 0; k2 < 4; ++k2) *(LAS u32x4*)((tl_) + (srow + 16 * k2) * 528 + schk * 16) = pre[k2]; } while (0)
        bf16x8 qf[2];
#pragma unroll
        for (int ks = 0; ks < 2; ++ks) qf[ks] = *(const bf16x8*)(P + (rowbase + t0 + qi) * LDP + PC_Q + hq * 64 + 8 * g4 + 32 * ks);
        DA_LOAD(0); DA_STORE(tile0);
        if (nsteps > 1) DA_LOAD(1);
        f32x4 oacc[4];
#pragma unroll
        for (int dt = 0; dt < 4; ++dt) oacc[dt] = (f32x4){0.f, 0.f, 0.f, 0.f};
        float mrun = 0.f, lrun = 0.f; bool seen = false;
        LDSW();
        __syncthreads();
#pragma unroll 1
        for (int st = 0; st < nsteps; ++st) {
            LAS unsigned char* cur = (st & 1) ? tile1 : tile0; LAS unsigned char* nxt = (st & 1) ? tile0 : tile1;
            if (st + 1 < nsteps) DA_STORE(nxt);
            if (st + 2 < nsteps) DA_LOAD(st + 2);
            f32x4 sc2[4];
#pragma unroll
            for (int sub = 0; sub < 4; ++sub) { f32x4 ac = (f32x4){0.f, 0.f, 0.f, 0.f};
#pragma unroll
                for (int ks = 0; ks < 2; ++ks) ac = __builtin_amdgcn_mfma_f32_16x16x32_bf16(*(const LAS bf16x8*)(cur + (16 * sub + c16) * 528 + g * 128 + (8 * g4 + 32 * ks) * 2), qf[ks], ac, 0, 0, 0);
                sc2[sub] = ac; }
            const u32x2 mw2 = *(const LAS u32x2*)&fsel[qi * 132 + 2 * st];
            const unsigned mwa = mw2.x >> (4 * g4), mwb = mw2.y >> (4 * g4);
            float lmax = -3.0e38f;
#pragma unroll
            for (int sub = 0; sub < 4; ++sub)
#pragma unroll
                for (int r = 0; r < 4; ++r) { const int sel = ((int)(((sub < 2) ? mwa : mwb) << (31 - (16 * (sub & 1) + r)))) >> 31;
                    const unsigned tb = __float_as_uint(__builtin_fmaf(sc2[sub][r], 0.18033688011112042f, -mrun));
                    const float t = __uint_as_float((tb & (unsigned)sel) | (0xff7fffffu & ~(unsigned)sel));
                    sc2[sub][r] = t; lmax = fmaxf(lmax, t); }
            if (__any(lmax > 11.5f || (!seen && lmax > -1e37f))) {
                float tm = fmaxf(lmax, __shfl_xor(lmax, 16)); tm = fmaxf(tm, __shfl_xor(tm, 32));
                const bool any_key = tm > -1e37f;
                const float dl = seen ? fmaxf(tm, 0.f) : (any_key ? tm : 0.f);
                seen = seen || any_key;
                const float alpha = __builtin_amdgcn_exp2f(-dl);
                lrun *= alpha; mrun += dl;
#pragma unroll
                for (int sub = 0; sub < 4; ++sub)
#pragma unroll
                    for (int r = 0; r < 4; ++r) sc2[sub][r] -= dl;
#pragma unroll
                for (int r = 0; r < 4; ++r) { const float ar = __shfl(alpha, 4 * g4 + r);
#pragma unroll
                    for (int dt = 0; dt < 4; ++dt) oacc[dt][r] *= ar; }
            }
            float pv[4][4];
#pragma unroll
            for (int sub = 0; sub < 4; ++sub)
#pragma unroll
                for (int r = 0; r < 4; ++r) { const float p = __builtin_amdgcn_exp2f(sc2[sub][r]); pv[sub][r] = p; lrun += p; }
            bf16x8 pa[2];
#pragma unroll
            for (int h2 = 0; h2 < 2; ++h2) { u32x4 pw; pw.x = cvt_pk_bf16(pv[2 * h2][0], pv[2 * h2][1]); pw.y = cvt_pk_bf16(pv[2 * h2][2], pv[2 * h2][3]); pw.z = cvt_pk_bf16(pv[2 * h2 + 1][0], pv[2 * h2 + 1][1]); pw.w = cvt_pk_bf16(pv[2 * h2 + 1][2], pv[2 * h2 + 1][3]); pa[h2] = __builtin_bit_cast(bf16x8, pw); }
#pragma unroll
            for (int dt = 0; dt < 4; ++dt)
#pragma unroll
                for (int h2 = 0; h2 < 2; ++h2) {
                    const LAS unsigned char* p0 = cur + (32 * h2 + 4 * g4 + (c16 >> 2)) * 528 + (128 + 64 * g + 16 * dt + 4 * (c16 & 3)) * 2;
                    const s16x4 a = __builtin_bit_cast(s16x4, __builtin_amdgcn_ds_read_tr16_b64_v4i16((LAS s16x4*)p0)), b = __builtin_bit_cast(s16x4, __builtin_amdgcn_ds_read_tr16_b64_v4i16((LAS s16x4*)(p0 + 16 * 528)));
                    oacc[dt] = __builtin_amdgcn_mfma_f32_16x16x32_bf16(pa[h2], (bf16x8){a[0], a[1], a[2], a[3], b[0], b[1], b[2], b[3]}, oacc[dt], 0, 0, 0);
                }
            LDSW();
            __syncthreads();
        }
#undef DA_LOAD
#undef DA_STORE
        float lt = lrun + __shfl_xor(lrun, 16); lt += __shfl_xor(lt, 32);
        const float invl = 1.0f / lt;
        bf16_t* orow = YB + (rowbase + t0 + 4 * qquad + g4) * LDY + 512 + (4 * g) * 64 + c16;
#pragma unroll
        for (int r = 0; r < 4; ++r) { const float ir = __shfl(invl, 4 * g4 + r);
#pragma unroll
            for (int dt = 0; dt < 4; ++dt) orow[r * 64 + 16 * dt] = (bf16_t)(cvt_pk_bf16(oacc[dt][r] * ir, 0.f) & 0xffffu); }
    }
    SEC_T1(23)
    } else {
    SEC_T0(24)
    LAS unsigned* lists = (LAS unsigned*)(lds + SA_LISTS + wave * 2048);
    int nsel2[2];
#pragma unroll
    for (int qq = 0; qq < 2; ++qq) {
        const int q = 2 * wave + qq;
        const LAS unsigned short* hgt = (const LAS unsigned short*)(lds + SA_GT) + (q & 3) * 4 + (q >> 2); const LAS unsigned short* heq = (const LAS unsigned short*)(lds + SA_EQ) + (q & 3) * 4 + (q >> 2);
#define SA_WORD(hp, j) ((unsigned)(hp)[(2 * (j)) * 16] | ((unsigned)(hp)[(2 * (j) + 1) * 16] << 16))
        unsigned g0 = SA_WORD(hgt, lane), g1 = SA_WORD(hgt, lane + 64), g2 = lane < 4 ? SA_WORD(hgt, lane + 128) : 0u;
        unsigned e0 = SA_WORD(heq, lane), e1 = SA_WORD(heq, lane + 64), e2 = lane < 4 ? SA_WORD(heq, lane + 128) : 0u;
#undef SA_WORD
        const unsigned krem = selall ? 0u : selp[16 + q];
        {
            const unsigned c0 = __popc(e0), c1 = __popc(e1), c2 = __popc(e2);
            const unsigned i0 = wave_incl_sum_u(c0, lane), i1 = wave_incl_sum_u(c1, lane), i2 = wave_incl_sum_u(c2, lane);
            const unsigned T0 = __shfl(i0, 63), T1 = __shfl(i1, 63);
            const unsigned x0 = i0 - c0, x1 = T0 + i1 - c1, x2 = T0 + T1 + i2 - c2;
            e0 = keep_low(e0, krem > x0 ? krem - x0 : 0u); e1 = keep_low(e1, krem > x1 ? krem - x1 : 0u); e2 = keep_low(e2, krem > x2 ? krem - x2 : 0u);
        }
        g0 |= e0; g1 |= e1; g2 |= e2;
        {
            LAS unsigned* list = lists + qq * 256;
            const unsigned c0 = __popc(g0), c1 = __popc(g1), c2 = __popc(g2);
            const unsigned i0 = wave_incl_sum_u(c0, lane), i1 = wave_incl_sum_u(c1, lane), i2 = wave_incl_sum_u(c2, lane);
            const unsigned T0 = __shfl(i0, 63), T1 = __shfl(i1, 63), T2 = __shfl(i2, 63);
            unsigned o0 = i0 - c0, o1 = T0 + i1 - c1, o2 = T0 + T1 + i2 - c2;
            int nsel = (int)(T0 + T1 + T2); nsel2[qq] = nsel > 256 ? 256 : nsel;
            while (g0) { const int b = __ffs(g0) - 1; if (o0 < 256u) list[o0] = (unsigned)(32 * lane + b) * 512u; ++o0; g0 &= g0 - 1u; }
            while (g1) { const int b = __ffs(g1) - 1; if (o1 < 256u) list[o1] = (unsigned)(32 * (lane + 64) + b) * 512u; ++o1; g1 &= g1 - 1u; }
            while (g2) { const int b = __ffs(g2) - 1; if (o2 < 256u) list[o2] = (unsigned)(32 * (lane + 128) + b) * 512u; ++o2; g2 &= g2 - 1u; }
#pragma unroll
            for (int i = 0; i < 4; ++i) if (lane + 64 * i >= nsel2[qq]) list[lane + 64 * i] = 0u;
        }
    }
    LDSW();
    __syncthreads();
    SEC_T1(24)
    LAS float* sP = (LAS float*)(lds + SA_SPS + wave * 8192);
    LAS unsigned char* vst = lds + wave * 4608;
#define SA_KLOAD(dst, kg0_) do { _Pragma("unroll") for (int u = 0; u < 4; ++u) { const unsigned off_ = list[16 * ((kg0_) + u) + c16] + 16u * (unsigned)g4; \
        const bf16_t* kvrow_ = (const bf16_t*)(kvb + off_); \
        _Pragma("unroll") for (int g = 0; g < 2; ++g) { dst[u][g][0] = *(const bf16x8*)(kvrow_ + g * 64); dst[u][g][1] = *(const bf16x8*)(kvrow_ + g * 64 + 32); } } } while (0)
#define SA_KCOMP(src, kg0_) do { _Pragma("unroll") for (int u = 0; u < 4; ++u) { const int kk_ = 16 * ((kg0_) + u) + c16; \
        _Pragma("unroll") for (int g = 0; g < 2; ++g) { \
            f32x4 ac_ = __builtin_amdgcn_mfma_f32_16x16x32_bf16(qa[g][0], src[u][g][0], (f32x4){0.f, 0.f, 0.f, 0.f}, 0, 0, 0); \
            ac_ = __builtin_amdgcn_mfma_f32_16x16x32_bf16(qa[g][1], src[u][g][1], ac_, 0, 0, 0); \
            if (g4 == 0) *(LAS f32x4*)&sP[kk_ * 8 + 4 * g] = ac_ * 0.125f; } } } while (0)
#define SA_VLOAD(dst, hf_, g_, kh_) do { _Pragma("unroll") for (int k2 = 0; k2 < 2; ++k2) _Pragma("unroll") for (int i = 0; i < 4; ++i) { const unsigned off_ = list[128 * (hf_) + 32 * (2 * (kh_) + k2) + 8 * i + (lane >> 3)] + 16u * (unsigned)(lane & 7); \
        dst[k2][i] = *(const u32x4*)(kvb + off_ + 256 + (g_) * 128); } } while (0)
#define SA_VCOMP(src, hf_, g_, kh_) do { _Pragma("unroll") for (int k2 = 0; k2 < 2; ++k2) { \
        _Pragma("unroll") for (int i = 0; i < 4; ++i) *(LAS u32x4*)(vst + (8 * i + (lane >> 3)) * 144 + (lane & 7) * 16) = src[k2][i]; \
        const bf16x8 pa_ = *(const LAS bf16x8*)((const LAS unsigned char*)sP + (4 * (g_) + (c16 & 3)) * 528 + (128 * (hf_) + 32 * (2 * (kh_) + k2) + 8 * g4) * 2); \
        _Pragma("unroll") for (int dt = 0; dt < 4; ++dt) { const LAS unsigned char* p0_ = vst + (8 * g4 + (c16 >> 2)) * 144 + (16 * dt + 4 * (c16 & 3)) * 2; \
            const s16x4 a_ = __builtin_bit_cast(s16x4, __builtin_amdgcn_ds_read_tr16_b64_v4i16((LAS s16x4*)p0_)), b_ = __builtin_bit_cast(s16x4, __builtin_amdgcn_ds_read_tr16_b64_v4i16((LAS s16x4*)(p0_ + 4 * 144))); \
            oacc[g_][dt] = __builtin_amdgcn_mfma_f32_16x16x32_bf16(pa_, (bf16x8){a_[0], a_[1], a_[2], a_[3], b_[0], b_[1], b_[2], b_[3]}, oacc[g_][dt], 0, 0, 0); } } } while (0)
#define SA_VOK(hf_, kh_) (128 * (hf_) + 64 * (kh_) < nsel)
#define SA_RED8(v, OP) do { \
        { const bool up_ = lane >= 32; _Pragma("unroll") for (int h = 0; h < 4; ++h) { const float mine_ = up_ ? v[4 + h] : v[h], send_ = up_ ? v[h] : v[4 + h]; v[h] = OP(mine_, __shfl_xor(send_, 32)); } } \
        { const bool up_ = (lane & 16) != 0; _Pragma("unroll") for (int h = 0; h < 2; ++h) { const float mine_ = up_ ? v[2 + h] : v[h], send_ = up_ ? v[h] : v[2 + h]; v[h] = OP(mine_, __shfl_xor(send_, 16)); } } \
        { const bool up_ = (lane & 8) != 0; const float mine_ = up_ ? v[1] : v[0], send_ = up_ ? v[0] : v[1]; v[0] = OP(mine_, __shfl_xor(send_, 8)); } \
        v[0] = OP(v[0], __shfl_xor(v[0], 1)); v[0] = OP(v[0], __shfl_xor(v[0], 2)); v[0] = OP(v[0], __shfl_xor(v[0], 4)); \
        { const float r_ = v[0]; _Pragma("unroll") for (int h = 0; h < 8; ++h) v[h] = __int_as_float(__builtin_amdgcn_readlane(__float_as_int(r_), 8 * h)); } } while (0)
#define SA_FMAX(a_, b_) fmaxf(a_, b_)
#define SA_FADD(a_, b_) ((a_) + (b_))
#pragma unroll 1
    for (int qq = 0; qq < 2; ++qq) {
        const int tq = t0 + 2 * wave + qq; const int nsel = qq ? nsel2[1] : nsel2[0];
        const LAS unsigned* list = lists + qq * 256;
        const char* kvb = (const char*)(KV + rowbase * 256);
        bf16x8 qa[2][2];
#pragma unroll
        for (int g = 0; g < 2; ++g)
#pragma unroll
            for (int ks = 0; ks < 2; ++ks) qa[g][ks] = *(const bf16x8*)(P + (rowbase + tq) * LDP + PC_Q + (4 * g + (c16 & 3)) * 64 + 8 * g4 + 32 * ks);
        const int ngrp = (nsel + 15) >> 4;
        u32x4 vrA[2][4], vrB[2][4];
        bf16x8 kbA[4][2][2], kbB[4][2][2];
        SA_KLOAD(kbA, 0);
        SEC_T0(21)
        if (ngrp > 4) SA_KLOAD(kbB, 4);
        SA_KCOMP(kbA, 0);
        if (ngrp > 4) {
            if (ngrp > 8) SA_KLOAD(kbA, 8);
            SA_KCOMP(kbB, 4);
            if (ngrp > 8) {
                if (ngrp > 12) SA_KLOAD(kbB, 12);
                SA_KCOMP(kbA, 8);
                if (ngrp > 12) SA_KCOMP(kbB, 12);
            }
        }
        SEC_T1(21)
        SEC_T0(25)
        SA_VLOAD(vrA, 0, 0, 0);
        LDSW();
        float inv[8];
        {
            f32x4 sa_[4][2]; float mx[8];
#pragma unroll
            for (int h = 0; h < 8; ++h) mx[h] = NINF;
#pragma unroll
            for (int i = 0; i < 4; ++i) { const int kk = lane + 64 * i;
                if (kk < nsel) { sa_[i][0] = *(const LAS f32x4*)&sP[kk * 8]; sa_[i][1] = *(const LAS f32x4*)&sP[kk * 8 + 4]; }
                else { sa_[i][0] = (f32x4){NINF, NINF, NINF, NINF}; sa_[i][1] = sa_[i][0]; }
#pragma unroll
                for (int h = 0; h < 8; ++h) mx[h] = fmaxf(mx[h], sa_[i][h >> 2][h & 3]); }
            LDSW();
            SA_RED8(mx, SA_FMAX);
            float sm[8];
#pragma unroll
            for (int h = 0; h < 8; ++h) sm[h] = 0.f;
#pragma unroll
            for (int i = 0; i < 4; ++i) { const int kk = lane + 64 * i;
#pragma unroll
                for (int h = 0; h < 8; ++h) { const float pv = (kk < nsel) ? fast_exp(sa_[i][h >> 2][h & 3] - mx[h]) : 0.f; sm[h] += pv;
                    *(LAS unsigned short*)((LAS unsigned char*)sP + h * 528 + kk * 2) = (unsigned short)(cvt_pk_bf16(pv, 0.f) & 0xffffu); } }
            SA_RED8(sm, SA_FADD);
#pragma unroll
            for (int h = 0; h < 8; ++h) inv[h] = 1.0f / sm[h];
        }
        LDSW();
        SEC_T1(25)
        SEC_T0(22)
        f32x4 oacc[2][4];
#pragma unroll
        for (int g = 0; g < 2; ++g)
#pragma unroll
            for (int dt = 0; dt < 4; ++dt) oacc[g][dt] = (f32x4){0.f, 0.f, 0.f, 0.f};
        if (SA_VOK(0, 1)) SA_VLOAD(vrB, 0, 0, 1);
        SA_VCOMP(vrA, 0, 0, 0);
        SA_VLOAD(vrA, 0, 1, 0);
        if (SA_VOK(0, 1)) SA_VCOMP(vrB, 0, 0, 1);
        if (SA_VOK(0, 1)) SA_VLOAD(vrB, 0, 1, 1);
        SA_VCOMP(vrA, 0, 1, 0);
        if (SA_VOK(1, 0)) SA_VLOAD(vrA, 1, 0, 0);
        if (SA_VOK(0, 1)) SA_VCOMP(vrB, 0, 1, 1);
        if (SA_VOK(1, 0)) {
            if (SA_VOK(1, 1)) SA_VLOAD(vrB, 1, 0, 1);
            SA_VCOMP(vrA, 1, 0, 0);
            SA_VLOAD(vrA, 1, 1, 0);
            if (SA_VOK(1, 1)) SA_VCOMP(vrB, 1, 0, 1);
            if (SA_VOK(1, 1)) SA_VLOAD(vrB, 1, 1, 1);
        }
        if (SA_VOK(1, 0)) {
            SA_VCOMP(vrA, 1, 1, 0);
            if (SA_VOK(1, 1)) SA_VCOMP(vrB, 1, 1, 1);
        }
        SEC_T1(22)
        SEC_T0(26)
        if (g4 == 0) {
            bf16_t* orow = YB + (rowbase + tq) * LDY + 512 + c16;
#pragma unroll
            for (int g = 0; g < 2; ++g)
#pragma unroll
                for (int dt = 0; dt < 4; ++dt)
#pragma unroll
                    for (int r = 0; r < 4; ++r) orow[(4 * g + r) * 64 + 16 * dt] = (bf16_t)(cvt_pk_bf16(oacc[g][dt][r] * inv[4 * g + r], 0.f) & 0xffffu);
        }
        LDSW();
        SEC_T1(26)
    }
#undef SA_KLOAD
#undef SA_KCOMP
#undef SA_VLOAD
#undef SA_VCOMP
#undef SA_VOK
#undef SA_RED8
#undef SA_FMAX
#undef SA_FADD
    }
    SEC_T1(15)
}

constexpr int QS = 272, WS_ = 144;
constexpr int MLA_KW = 0, MLA_V = 64 * QS, MLA_SCR = 2 * 64 * QS;
constexpr int MLC_Q = 0, MLC_K = 64 * QS, MLC_V = 2 * 64 * QS, MLC_MO = 3 * 64 * QS, MLC_W = 4 * 64 * QS  , MLC_SCR = MLC_W + 64 * WS_  , MLC_SS = MLC_SCR + 8 * 1024, MLC_N = MLC_SS + 2048, MLC_QN = MLC_N + 512, MLC_R = MLC_QN + 256;
constexpr size_t CB_CHUNK = 128 * 128;
__device__ __forceinline__ bf16x8 tr_frag(const LAS unsigned char* img, int r0, int r1, int col0, int c16) {
    const LAS unsigned char* p0 = img + (r0 + (c16 >> 2)) * QS + (col0 + 4 * (c16 & 3)) * 2; const LAS unsigned char* p1 = img + (r1 + (c16 >> 2)) * QS + (col0 + 4 * (c16 & 3)) * 2;
    const s16x4 a = __builtin_bit_cast(s16x4, __builtin_amdgcn_ds_read_tr16_b64_v4i16((LAS s16x4*)p0)), b = __builtin_bit_cast(s16x4, __builtin_amdgcn_ds_read_tr16_b64_v4i16((LAS s16x4*)p1));
    return (bf16x8){a[0], a[1], a[2], a[3], b[0], b[1], b[2], b[3]};
}
__device__ __forceinline__ bf16x8 mk_frag(u32x2 lo, u32x2 hi) { u32x4 w; w.x = lo.x; w.y = lo.y; w.z = hi.x; w.w = hi.y; return __builtin_bit_cast(bf16x8, w); }
__device__ __forceinline__ void ml_gates(const bf16_t* P, size_t rowbase, int c, int hd, float bi, float bfg, int lane, float& logi, float& lf) {
    const int tt = 64 * c - 48 + lane; logi = -__builtin_inff(); lf = 0.f;
    if (tt >= 0) { const bf16_t* gp = P + (rowbase + tt) * LDP; logi = bf2f(gp[PC_MI + hd]) + bi; const float f = bf2f(gp[PC_MF + hd]) + bfg; lf = fminf(f, 0.f) - __builtin_amdgcn_logf(1.0f + fast_exp(-fabsf(f))) * 0.69314718056f; }
}

__device__ __forceinline__ void mlA_item(LAS unsigned char* lds, const bf16_t* P, const float* b_i, const float* b_f, bf16_t* CB, float* NB, float* SC, int bl, int hd, int c, int tid, int lane, int wave) {
    asm volatile("" : "+v"(tid)); lane = tid & 63;
    const size_t rowbase = (size_t)bl * T; const int c16 = lane & 15, g4 = lane >> 4;
    const size_t slot = (size_t)(bl * 4 + hd) * 65 + c;
    const int sl = tid >> 4, scc = tid & 15;
    u32x4 pk[2], pv[2];
#pragma unroll
    for (int k2 = 0; k2 < 2; ++k2) { const int tt = 64 * c - 48 + sl + 32 * k2;
        if (tt >= 0) { const bf16_t* rp = P + (rowbase + tt) * LDP + PC_MK + hd * 128 + 8 * scc; pk[k2] = __builtin_nontemporal_load((const u32x4*)rp); pv[k2] = __builtin_nontemporal_load((const u32x4*)(rp + 512)); }
        else { pk[k2] = (u32x4){0u, 0u, 0u, 0u}; pv[k2] = pk[k2]; } }
    float logi, lf; ml_gates(P, rowbase, c, hd, b_i[hd], b_f[hd], lane, logi, lf);
    const float b = wave_incl_sum(lf, lane), av = logi - b, A63 = wave_max(av), bL = __shfl(b, 63);
    LAS float* sW = (LAS float*)(lds + MLA_SCR + wave * 256);
    sW[lane] = fast_exp(av - A63) * 0.08838834764831845f;
    LDSW();
#pragma unroll
    for (int k2 = 0; k2 < 2; ++k2) { const int l = sl + 32 * k2; const int o = l * QS + scc * 16; const float wk = sW[l]; u32x4 kw;
#pragma unroll
        for (int j = 0; j < 4; ++j) kw[j] = cvt_pk_bf16(bf_lo(pk[k2][j]) * wk, bf_hi(pk[k2][j]) * wk);
        *(LAS u32x4*)(lds + MLA_KW + o) = kw; *(LAS u32x4*)(lds + MLA_V + o) = pv[k2]; }
    LDSW();
    __syncthreads();
    bf16x8 vf[2];
#pragma unroll
    for (int ks = 0; ks < 2; ++ks) vf[ks] = tr_frag(lds + MLA_V, 32 * ks + 8 * g4, 32 * ks + 8 * g4 + 4, 16 * wave, c16);
    f32x4 acc[8];
#pragma unroll
    for (int dt = 0; dt < 8; ++dt) { f32x4 cc = (f32x4){0.f, 0.f, 0.f, 0.f};
#pragma unroll
        for (int ks = 0; ks < 2; ++ks) cc = __builtin_amdgcn_mfma_f32_16x16x32_bf16(tr_frag(lds + MLA_KW, 32 * ks + 8 * g4, 32 * ks + 8 * g4 + 4, 16 * dt, c16), vf[ks], cc, 0, 0, 0);
        acc[dt] = cc; }
    u32x4* cb = (u32x4*)(CB + slot * CB_CHUNK) + (wave * 4) * 64 + lane;
#pragma unroll
    for (int kd = 0; kd < 4; ++kd) __builtin_nontemporal_store(pg8::pack8(acc[2 * kd], acc[2 * kd + 1]), cb + kd * 64);
    if (tid < 64) { float s0 = 0.f, s1 = 0.f;
#pragma unroll 16
        for (int sr = 0; sr < 64; ++sr) { const unsigned w = *(const LAS unsigned*)(lds + MLA_KW + sr * QS + tid * 4); s0 += bf_lo(w); s1 += bf_hi(w); }
        *(f32x2*)(NB + slot * 128 + 2 * tid) = (f32x2){s0, s1};
        if (tid == 0) { SC[slot * 2] = bL; SC[slot * 2 + 1] = A63; } }
}

__device__ __forceinline__ void mlB_scan(bf16_t* CB, float* NB, const float* SC, float* MB, int blk, int nthreads, int wave_id) {
    int tid_ = wave_id * 64 + fresh_lane(); asm volatile("" : "+v"(tid_)); const int gtid = blk * 512 + tid_;
    for (int wi = gtid; wi < 32 * 4096; wi += nthreads) {
        const int chain = wi >> 12, e4 = wi & 4095;
        u32x2* cp = (u32x2*)(CB + (size_t)chain * 65 * CB_CHUNK) + e4;
        const f32x2* sc = (const f32x2*)(SC + (size_t)chain * 65 * 2);
        f32x4 st = (f32x4){0.f, 0.f, 0.f, 0.f}; float m = 0.f;
#pragma unroll 1
        for (int c0 = 0; c0 < 65; c0 += 13) {
            u32x2 d[13]; f32x2 s2[13];
#pragma unroll
            for (int i = 0; i < 13; ++i) { d[i] = cp[(size_t)(c0 + i) * (CB_CHUNK / 4)]; s2[i] = sc[c0 + i]; }
#pragma unroll
            for (int i = 0; i < 13; ++i) {
                const float bL = s2[i].x, A63 = s2[i].y;
                const float Mx = fmaxf(m, A63), dec = fast_exp(m - Mx), sca = fast_exp(A63 - Mx);
                u32x2 o; o.x = cvt_pk_bf16(st[0], st[1]); o.y = cvt_pk_bf16(st[2], st[3]); cp[(size_t)(c0 + i) * (CB_CHUNK / 4)] = o;
                st = st * dec + (f32x4){bf_lo(d[i].x), bf_hi(d[i].x), bf_lo(d[i].y), bf_hi(d[i].y)} * sca;
                m = bL + Mx;
            }
        }
    }
    for (int wi = gtid; wi < 32 * 32; wi += nthreads) {
        const int chain = wi >> 5, e4 = wi & 31;
        f32x4* np = (f32x4*)(NB + (size_t)chain * 65 * 128) + e4;
        const f32x2* sc = (const f32x2*)(SC + (size_t)chain * 65 * 2);
        f32x4 nst = (f32x4){0.f, 0.f, 0.f, 0.f}; float m = 0.f;
#pragma unroll 1
        for (int c0 = 0; c0 < 65; c0 += 13) {
            f32x4 d[13]; f32x2 s2[13];
#pragma unroll
            for (int i = 0; i < 13; ++i) { d[i] = np[(c0 + i) * 32]; s2[i] = sc[c0 + i]; }
#pragma unroll
            for (int i = 0; i < 13; ++i) {
                const float bL = s2[i].x, A63 = s2[i].y;
                const float Mx = fmaxf(m, A63), dec = fast_exp(m - Mx), sca = fast_exp(A63 - Mx);
                np[(c0 + i) * 32] = nst; nst = nst * dec + d[i] * sca;
                if (e4 == 0) MB[chain * 65 + c0 + i] = m;
                m = bL + Mx;
            }
        }
    }
}

__device__ __forceinline__ void mlC_item(LAS unsigned char* lds, const bf16_t* P, bf16_t* YB, const float* b_i, const float* b_f, const float* mh_g, const bf16_t* CB, const float* NB, const float* MB, int bl, int hd, int c, int tid, int lane, int wave) {
    asm volatile("" : "+v"(tid)); lane = tid & 63;
    const size_t rowbase = (size_t)bl * T; const int c16 = lane & 15, g4 = lane >> 4;
    const size_t slot = (size_t)(bl * 4 + hd) * 65 + c;
    LAS float* scr = (LAS float*)(lds + MLC_SCR + wave * 1024);
    LAS float* sA = scr, *sM = scr + 64, *sI = scr + 128, *sE = scr + 192;
    LAS float* sss = (LAS float*)(lds + MLC_SS); LAS float* sn = (LAS float*)(lds + MLC_N); LAS float* sqn = (LAS float*)(lds + MLC_QN); LAS float* sR = (LAS float*)(lds + MLC_R);
    const int sl = tid >> 4, scc = tid & 15;
    u32x4 pq[2], pk[2], pv[2], po[2];
#pragma unroll
    for (int k2 = 0; k2 < 2; ++k2) { const int tt = 64 * c - 48 + sl + 32 * k2;
        if (tt >= 0) { const bf16_t* rp = P + (rowbase + tt) * LDP + PC_MQ + hd * 128 + 8 * scc; pq[k2] = *(const u32x4*)rp; pk[k2] = *(const u32x4*)(rp + 512); pv[k2] = *(const u32x4*)(rp + 1024); po[k2] = *(const u32x4*)(rp + 1536); }
        else { pq[k2] = (u32x4){0u, 0u, 0u, 0u}; pk[k2] = pq[k2]; pv[k2] = pq[k2]; po[k2] = pq[k2]; } }
    u32x4 cfr[4];
    { const u32x4* cb = (const u32x4*)(CB + slot * CB_CHUNK) + (wave * 4) * 64 + lane;
#pragma unroll
      for (int kd = 0; kd < 4; ++kd) cfr[kd] = cb[kd * 64]; }
    const float mprev = MB[slot];
    if (tid < 128) sn[tid] = NB[slot * 128 + tid];
    const float gmh = mh_g[hd * 128 + 16 * wave + c16];
    {
        float logi, lf; ml_gates(P, rowbase, c, hd, b_i[hd], b_f[hd], lane, logi, lf);
        const float b = wave_incl_sum(lf, lane), av = logi - b, Am = wave_incl_max(av, lane), Mx = fmaxf(mprev, Am);
        sA[lane] = av; sM[lane] = Mx; sI[lane] = fast_exp(mprev - Mx); sE[lane] = fast_exp(-(b + Mx));
    }
#pragma unroll
    for (int k2 = 0; k2 < 2; ++k2) { const int o = (sl + 32 * k2) * QS + scc * 16;
        *(LAS u32x4*)(lds + MLC_Q + o) = pq[k2]; *(LAS u32x4*)(lds + MLC_K + o) = pk[k2]; *(LAS u32x4*)(lds + MLC_V + o) = pv[k2]; *(LAS u32x4*)(lds + MLC_MO + o) = po[k2]; }
    LDSW();
    __syncthreads();
    {
        const int tok = 8 * wave + (lane >> 3), dch = lane & 7;
        const u32x4 q0 = *(const LAS u32x4*)(lds + MLC_Q + tok * QS + dch * 32), q1 = *(const LAS u32x4*)(lds + MLC_Q + tok * QS + dch * 32 + 16);
        float acc = 0.f;
#pragma unroll
        for (int j = 0; j < 4; ++j) { const f32x4 n4 = *(const LAS f32x4*)&sn[16 * dch + 4 * j]; const unsigned wa = j < 2 ? q0[2 * j] : q1[2 * j - 4], wb = j < 2 ? q0[2 * j + 1] : q1[2 * j - 3];
            acc += bf_lo(wa) * n4[0] + bf_hi(wa) * n4[1] + bf_lo(wb) * n4[2] + bf_hi(wb) * n4[3]; }
        acc += __shfl_xor(acc, 1); acc += __shfl_xor(acc, 2); acc += __shfl_xor(acc, 4);
        if (dch == 0) sqn[tok] = acc;
    }
    {
        const int lt = wave >> 1;
        bf16x8 qf[4];
#pragma unroll
        for (int kd = 0; kd < 4; ++kd) qf[kd] = *(const LAS bf16x8*)(lds + MLC_Q + (16 * lt + c16) * QS + (32 * kd + 8 * g4) * 2);
        const float Ml = sM[16 * lt + c16];
#pragma unroll
        for (int hh = 0; hh < 2; ++hh) { const int st = (wave & 1) + 2 * hh;
            u32x2 w = (u32x2){0u, 0u};
            if (st <= lt) {
                f32x4 ac = (f32x4){0.f, 0.f, 0.f, 0.f};
#pragma unroll
                for (int kd = 0; kd < 4; ++kd) { const bf16x8 kf = *(const LAS bf16x8*)(lds + MLC_K + (16 * st + c16) * QS + (32 * kd + 8 * g4) * 2); ac = __builtin_amdgcn_mfma_f32_16x16x32_bf16(kf, qf[kd], ac, 0, 0, 0); }
                const f32x4 a4 = *(const LAS f32x4*)&sA[16 * st + 4 * g4];
                float val[4];
#pragma unroll
                for (int r = 0; r < 4; ++r) { const int sI_ = 16 * st + 4 * g4 + r, l = 16 * lt + c16; val[r] = (sI_ <= l) ? fast_exp(a4[r] - Ml) * ac[r] * 0.08838834764831845f : 0.f; }
                w.x = cvt_pk_bf16(val[0], val[1]); w.y = cvt_pk_bf16(val[2], val[3]);
            }
            *(LAS u32x2*)(lds + MLC_W + (16 * lt + c16) * WS_ + (16 * st + 4 * g4) * 2) = w; }
    }
    LDSW();
    __syncthreads();
    {
        const int tok = 8 * wave + (lane >> 3), ch = lane & 7;
        const u32x4 w = *(const LAS u32x4*)(lds + MLC_W + tok * WS_ + ch * 16);
        float acc = (bf_lo(w.x) + bf_hi(w.x)) + (bf_lo(w.y) + bf_hi(w.y)) + (bf_lo(w.z) + bf_hi(w.z)) + (bf_lo(w.w) + bf_hi(w.w));
        acc += __shfl_xor(acc, 1); acc += __shfl_xor(acc, 2); acc += __shfl_xor(acc, 4);
        if (ch == 0) sR[tok] = acc;
    }
    f32x4 num[4];
    {
        bf16x8 vf[2];
#pragma unroll
        for (int ks = 0; ks < 2; ++ks) vf[ks] = tr_frag(lds + MLC_V, 32 * ks + 8 * g4, 32 * ks + 8 * g4 + 4, 16 * wave, c16);
#pragma unroll
        for (int lt = 0; lt < 4; ++lt) {
            f32x4 ah = (f32x4){0.f, 0.f, 0.f, 0.f}, aqc = (f32x4){0.f, 0.f, 0.f, 0.f};
#pragma unroll
            for (int ks = 0; ks < 2; ++ks) ah = __builtin_amdgcn_mfma_f32_16x16x32_bf16(*(const LAS bf16x8*)(lds + MLC_W + (16 * lt + c16) * WS_ + (32 * ks + 8 * g4) * 2), vf[ks], ah, 0, 0, 0);
#pragma unroll
            for (int kd = 0; kd < 4; ++kd) { const LAS unsigned char* qp = lds + MLC_Q + (16 * lt + c16) * QS + (32 * kd + 4 * g4) * 2;
                aqc = __builtin_amdgcn_mfma_f32_16x16x32_bf16(mk_frag(*(const LAS u32x2*)qp, *(const LAS u32x2*)(qp + 32)), __builtin_bit_cast(bf16x8, cfr[kd]), aqc, 0, 0, 0); }
            const f32x4 in4 = *(const LAS f32x4*)&sI[16 * lt + 4 * g4];
            num[lt] = in4 * aqc + ah;
        }
    }
    LDSW();
    __syncthreads();
#pragma unroll
    for (int lt = 0; lt < 4; ++lt) {
        const f32x4 qn4 = *(const LAS f32x4*)&sqn[16 * lt + 4 * g4], e4 = *(const LAS f32x4*)&sE[16 * lt + 4 * g4], in4 = *(const LAS f32x4*)&sI[16 * lt + 4 * g4], r4 = *(const LAS f32x4*)&sR[16 * lt + 4 * g4];
        f32x4 sq;
#pragma unroll
        for (int r = 0; r < 4; ++r) { const float den = in4[r] * qn4[r] + r4[r]; const float hv = num[lt][r] * __builtin_amdgcn_rcpf(fmaxf(fabsf(den), e4[r])); num[lt][r] = hv; sq[r] = hv * hv; }
#pragma unroll
        for (int o = 1; o < 16; o <<= 1) { sq[0] += __shfl_xor(sq[0], o); sq[1] += __shfl_xor(sq[1], o); sq[2] += __shfl_xor(sq[2], o); sq[3] += __shfl_xor(sq[3], o); }
        if (c16 == 0) *(LAS f32x4*)&sss[wave * 64 + 16 * lt + 4 * g4] = sq;
    }
    LDSW();
    __syncthreads();
#pragma unroll
    for (int lt = 0; lt < 4; ++lt) {
        f32x4 ss = (f32x4){0.f, 0.f, 0.f, 0.f};
#pragma unroll
        for (int w8 = 0; w8 < 8; ++w8) ss += *(const LAS f32x4*)&sss[w8 * 64 + 16 * lt + 4 * g4];
#pragma unroll
        for (int r = 0; r < 4; ++r) { const int l = 16 * lt + 4 * g4 + r; const int tt = 64 * c - 48 + l;
            const float mo = bf2f(*(const LAS unsigned short*)(lds + MLC_MO + l * QS + (16 * wave + c16) * 2));
            const float yv = num[lt][r] * __builtin_amdgcn_rsqf(ss[r] * (1.0f / 128.0f) + EPS) * gmh * sigmoidf_(mo);
            if (tt >= 0) YB[(rowbase + tt) * LDY + 1024 + hd * 128 + 16 * wave + c16] = (bf16_t)(cvt_pk_bf16(yv, 0.f) & 0xffffu); }
    }
}


struct Args { const float* in[12]; float* out; unsigned char* ws; };

__device__ __forceinline__ void convert_layer(const Args& a, int l, unsigned char* wgu0, unsigned char* wgu1, bf16_t* wdn0, bf16_t* wdn1, unsigned char* win, bf16_t* winb, bf16_t* wbr, bf16_t* wout, float* swgu0, float* swgu1, float* swin, LAS float* scr, int wave, int cblk, int G, int lane) {
    constexpr int N_GU8 = NGU / 32, N_IN8 = NWIN / 32, N_DN = (DM / 32) * (DFF / 64), N_BR1 = (DM / 32) * (512 / 64), N_OUT = (DM / 32) * (DM / 64), N_INB = (NWIN / 32) * (DM / 64);
    constexpr int NITEMS = 2 * N_GU8 + N_IN8 + 2 * N_DN + 3 * N_BR1 + N_OUT + N_INB;
    const float* sgu = a.in[3] + (size_t)l * 2 * DM * NGU; const float* sdn = a.in[4] + (size_t)l * 2 * DFF * DM;
    const float* sin_ = a.in[5] + (size_t)l * DM * INW; const float* sbr = a.in[10] + (size_t)l * 3 * 512 * DM; const float* sout = a.in[11] + (size_t)l * DM * DM;
    for (int it = wave * G + cblk; it < NITEMS; it += 8 * G) {
        int r = it;
        if (r < N_GU8) { cvt8_item(sgu, DM, NGU, wgu0, swgu0, scr, r, lane, map_gu); continue; } r -= N_GU8;
        if (r < N_GU8) { cvt8_item(sgu + (size_t)DM * NGU, DM, NGU, wgu1, swgu1, scr, r, lane, map_gu); continue; } r -= N_GU8;
        if (r < N_IN8) { cvt8_item(sin_, DM, INW, win, swin, scr, r, lane, map_win); continue; } r -= N_IN8;
        if (r < N_DN) { cvt_item(sdn, DFF, DM, wdn0, scr, r, lane, map_id); continue; } r -= N_DN;
        if (r < N_DN) { cvt_item(sdn + (size_t)DFF * DM, DFF, DM, wdn1, scr, r, lane, map_id); continue; } r -= N_DN;
        if (r < 3 * N_BR1) { const int br = r / N_BR1; cvt_item(sbr + (size_t)br * 512 * DM, 512, DM, wbr + (size_t)br * DM * 512, scr, r - br * N_BR1, lane, map_id); continue; } r -= 3 * N_BR1;
        if (r < N_OUT) { cvt_item(sout, DM, DM, wout, scr, r, lane, map_id); continue; } r -= N_OUT;
        cvt_item(sin_, DM, INW, winb, scr, r, lane, map_win);
    }
}

template <class Tp> __device__ __forceinline__ Tp* opq(Tp* p) { unsigned long long v = (unsigned long long)p; asm volatile("" : "+s"(v)); return (Tp*)(__attribute__((address_space(1))) Tp*)v; }
#define GRID_BAR() do { XcdBarrier b_ = bar; asm volatile("" : "+s"(b_.x)); xcd_barrier(b_); if (BAR_TWICE) xcd_barrier(b_); } while (0)

#define P_BEGIN(id) unsigned long long pt0_ = 0; if ((PROBE_ID >> (id)) & 1) pt0_ = __builtin_amdgcn_s_memrealtime();
#define P_END(id) if ((PROBE_ID >> (id)) & 1) { const unsigned long long pt1_ = __builtin_amdgcn_s_memrealtime(); const unsigned long long d_ = pt1_ - pt0_; while (__builtin_amdgcn_s_memrealtime() - pt1_ < d_) __builtin_amdgcn_s_sleep(8); GRID_BAR(); }

__global__ void __launch_bounds__(512, 2) fwd_kernel(Args a) {
    extern __shared__ __attribute__((aligned(16))) unsigned char lds_raw[];
    LAS unsigned char* lds = (LAS unsigned char*)lds_raw;
    const int wave = __builtin_amdgcn_readfirstlane((int)threadIdx.x >> 6);
    const int G = gridDim.x, c = blockIdx.x;
    const int gw = c * 8 + wave, NGW = G * 8;
    volatile LAS unsigned* MISC = (volatile LAS unsigned*)(lds + LDSCTL_OFF);
    if (wave == 0) MISC[fresh_lane()] = 0u;
#define lane fresh_lane()
#define tid (wave * 64 + fresh_lane())
    __syncthreads();
    XcdBarrier bar = xcd_barrier_post((unsigned*)(a.ws + WS_CTL) + CW_BAR, MISC, wave);
#define WSP(T_, off) ((T_*)(w_ + (off)))

    { P_BEGIN(19) { unsigned char* w_ = opq(a.ws);
      float* ctab = WSP(float, WS_COS); float* stab = WSP(float, WS_SIN);
      int tid0_ = tid; asm volatile("" : "+v"(tid0_));
      for (int i = c * 512 + tid0_; i < T * 32; i += G * 512) { const int t = i >> 5, j = i & 31;
          const float inv = 1.0f / powf(10000.0f, (float)(2 * j) / 64.0f); const float ang = (float)t * inv; ctab[i] = cosf(ang); stab[i] = sinf(ang); }
      convert_layer(a, 0, WSP(unsigned char, WS_WGU0), WSP(unsigned char, WS_WGU1), WSP(bf16_t, WS_WDN0), WSP(bf16_t, WS_WDN1), WSP(unsigned char, WS_WIN8), WSP(bf16_t, WS_WIN), WSP(bf16_t, WS_WBR), WSP(bf16_t, WS_WOUT), WSP(float, WS_SW), WSP(float, WS_SW) + 8192, WSP(float, WS_SW) + 16384, (LAS float*)(lds + wave * 16384), wave, c, G, lane);
      hres_t* H = WSP(hres_t, WS_H); unsigned char* U8 = (unsigned char*)opq(a.out); float* SU = WSP(float, WS_SU); const float* g0 = opq(a.in[2]);
      init_pass(a.in[0], a.in[1], H, U8, SU, g0, gw, NGW, lane); }
    GRID_BAR(); P_END(19) }

    int stage = 0;
#pragma unroll 1
    for (int l = 0; l < DEPTH; ++l) {
#pragma unroll 1
        for (int f = 0; f < 2; ++f) {
            if (stage >= DBG_STOP) break;
            { P_BEGIN(1) { unsigned char* w_ = opq(a.ws);
              pg8::Gemm gm{f ? (const char*)(w_ + WS_U8B) : (const char*)opq(a.out), nullptr, nullptr, (const char*)(w_ + (f ? WS_WGU1 : WS_WGU0)), 0, DM / 2, DM / 2, DM / 2, 0}; pg8::Sched S; S.init(M / 256, NGU / 256, 1, G, c);
              pg8::EpiSwiglu E{WSP(bf16_t, WS_BIG), DFF, WSP(float, WS_SU), WSP(float, WS_SW) + (f ? 8192 : 0), lds}; pg8::gemm_phase<pg8::EpiSwiglu, true>(lds, gm, S, E, wave); }
            GRID_BAR(); P_END(1) }
            { P_BEGIN(2) { unsigned char* w_ = opq(a.ws); pg8::Gemm gm{(const char*)(w_ + WS_BIG), nullptr, nullptr, (const char*)(w_ + (f ? WS_WDN1 : WS_WDN0)), 0, DFF, DFF, DFF, 0}; pg8::Sched S; S.init(MT / 256, DM / 256, 1, G, c);
              pg8::EpiBf16 E{WSP(bf16_t, WS_Y), DM}; pg8::gemm_phase(lds, gm, S, E, wave);
              pg8::Gemm gt{(const char*)(w_ + WS_BIG) + (size_t)MT * DFF * 2, nullptr, nullptr, (const char*)(w_ + (f ? WS_WDN1 : WS_WDN0)), 512, DFF, DFF, 256, 512}; pg8::Sched St; St.init(1, DM / 256, DFF / 256, G, c, true);
              pg8::EpiPartF32 Et{WSP(float, WS_YT), DM}; pg8::gemm_phase(lds, gt, St, Et, wave); }
            GRID_BAR(); P_END(2) }
            { P_BEGIN(3) { unsigned char* w_ = opq(a.ws); const bf16_t* Y = WSP(bf16_t, WS_Y); hres_t* H = WSP(hres_t, WS_H); unsigned char* U8 = (unsigned char*)opq(a.out); float* SU = WSP(float, WS_SU);
              const float* g = opq(a.in[2]) + (size_t)l * 6 * DM; const float* ga = g + (f ? 5 : 1) * DM;
              const float* gb = f ? opq(a.in[2]) + (size_t)(l + 1 < DEPTH ? l + 1 : l) * 6 * DM : g + 2 * DM;
              float* YT = WSP(float, WS_YT);
              norm_pass(Y, H, U8, SU, f ? nullptr : (bf16_t*)Y, ga, gb, 0.5f, gw, NGW, lane);
              for (int r = MT + gw; r < M; r += NGW) norm_row(Y + (size_t)r * DM, YT + (size_t)(r - MT) * DM, DFF / 256, H + (size_t)r * DM, U8 + (size_t)r * DM, SU + r, f ? nullptr : (bf16_t*)Y + (size_t)r * DM, ga, gb, 0.5f, lane);
              if (f == 1 && l + 1 < DEPTH) convert_layer(a, l + 1, WSP(unsigned char, WS_WGU0), WSP(unsigned char, WS_WGU1), WSP(bf16_t, WS_WDN0), WSP(bf16_t, WS_WDN1), WSP(unsigned char, WS_WIN8), WSP(bf16_t, WS_WIN), WSP(bf16_t, WS_WBR), WSP(bf16_t, WS_WOUT), WSP(float, WS_SW), WSP(float, WS_SW) + 8192, WSP(float, WS_SW) + 16384, (LAS float*)(lds + wave * 16384), wave, c, G, lane); }
            GRID_BAR(); P_END(3) }
            ++stage;
            if (f == 1) break;
            if (stage >= DBG_STOP) break;
#pragma unroll 1
            for (int hb = 0; hb < 2; ++hb) {
                { P_BEGIN(4) { unsigned char* w_ = opq(a.ws);
                  if (WIN_INT8) { pg8::Gemm gm{(const char*)opq(a.out) + (size_t)hb * MH * DM, nullptr, nullptr, (const char*)(w_ + WS_WIN8), 0, DM / 2, DM / 2, DM / 2, 0}; pg8::Sched S; S.init(MHP / 256, 20, 1, G, (c + G - (MHP / 256 * 11) % G) % G); S.pn0 = 6; S.gap_at = 4; S.gap = 5;
                    pg8::EpiWin E{WSP(bf16_t, WS_BIG), WSP(bf16_t, WS_GT), WSP(bf16_t, WS_KV), WSP(bf16_t, WS_KI), WSP(float, WS_COS), WSP(float, WS_SIN), WSP(float, WS_SU) + (size_t)hb * MH, WSP(float, WS_SW) + 16384, lds}; pg8::gemm_phase<pg8::EpiWin, true>(lds, gm, S, E, wave); }
                  { pg8::Gemm gm{(const char*)(WSP(bf16_t, WS_Y) + (size_t)hb * MH * DM), nullptr, nullptr, (const char*)(w_ + WS_WIN), 0, DM, DM, DM, 0}; pg8::Sched S; S.init(MHP / 256, WIN_INT8 ? 11 : 31, 1, G, c); if (WIN_INT8) { S.gap_at = 6; S.gap = 4; }
                    pg8::EpiWin E{WSP(bf16_t, WS_BIG), WSP(bf16_t, WS_GT), WSP(bf16_t, WS_KV), WSP(bf16_t, WS_KI), WSP(float, WS_COS), WSP(float, WS_SIN), nullptr, nullptr, lds}; pg8::gemm_phase(lds, gm, S, E, wave); } }
                GRID_BAR(); P_END(4) }
                { P_BEGIN(5) { unsigned char* w_ = opq(a.ws); unsigned* qbase = WSP(unsigned, WS_CTL) + CW_QUEUE + 64 * 8 * ((l * 2 + hb) * 2);
                  bf16_t* P = WSP(bf16_t, WS_BIG); unsigned char* ob = (unsigned char*)opq(a.out);
                  constexpr int N_ML = 260, N_SA = 257, N_CV = 33;
                  const int myq = (int)(bar.x & 7u);
                  constexpr unsigned NQ = N_ML + N_SA + N_CV;
                  int qoff = 0, itw;
                  __syncthreads();
                  if (tid == 0) { int it = -1, qq = 0; for (; qq < 8; ++qq) { const int qid = (myq + qq) & 7; const unsigned v = atomicAdd(qbase + 64 * qid, 1u); if (v < NQ) { it = (int)v | (qid << 16); break; } } MISC[4] = (unsigned)it; MISC[5] = (unsigned)qq; }
                  __syncthreads();
                  itw = (int)MISC[4]; qoff = (int)MISC[5];
                  while (itw >= 0) {
                      __syncthreads();
                      unsigned nv = 0u; const bool t0_ = (tid == 0);
                      if (t0_) nv = atomicAdd(qbase + 64 * ((myq + qoff) & 7), 1u);
                      const int item = itw & 0xffff, bl = itw >> 16;
                      unsigned long long it0_ = 0; if (PROBE_ID >> 9) it0_ = __builtin_amdgcn_s_memrealtime();
                      if (item < N_ML) mlA_item(lds, P, opq(a.in[7]) + l * 4, opq(a.in[8]) + l * 4, (bf16_t*)(ob + OB_CB), (float*)(ob + OB_NB), (float*)(ob + OB_SC), bl, item / 65, item % 65, tid, lane, wave);
                      else if (item < N_ML + N_SA) selattn_item(lds, P, (bf16_t*)(ob + OB_YB), WSP(bf16_t, WS_KV), WSP(bf16_t, WS_KI), bl, 256 - (item - N_ML), tid, lane, wave);
                      else conv_item(P, (bf16_t*)(ob + OB_YB), opq(a.in[6]) + (size_t)l * 3 * 512, bl, item - N_ML - N_SA, tid);
                      if (PROBE_ID >> 9) { const int kind = item < N_ML ? 9 : (item < N_ML + N_SA ? 10 : 11);
                          if ((PROBE_ID >> kind) & 1) { const unsigned long long it1_ = __builtin_amdgcn_s_memrealtime(); const unsigned long long d_ = it1_ - it0_; while (__builtin_amdgcn_s_memrealtime() - it1_ < d_) __builtin_amdgcn_s_sleep(8); } }
                      if (t0_) { int it = -1, qq = qoff; unsigned v = nv;
                          for (;;) { if (v < NQ) { it = (int)v | (((myq + qq) & 7) << 16); break; } if (++qq >= 8) break; v = atomicAdd(qbase + 64 * ((myq + qq) & 7), 1u); }
                          MISC[4] = (unsigned)it; MISC[5] = (unsigned)qq; }
                      __syncthreads();
                      itw = (int)MISC[4]; qoff = (int)MISC[5];
                  } }
                GRID_BAR(); P_END(5) }
                { P_BEGIN(17) { unsigned char* ob = (unsigned char*)opq(a.out);
                  mlB_scan((bf16_t*)(ob + OB_CB), (float*)(ob + OB_NB), (const float*)(ob + OB_SC), (float*)(ob + OB_MB), c, G * 512, wave); }
                GRID_BAR(); P_END(17) }
                { P_BEGIN(18) { unsigned char* w_ = opq(a.ws); unsigned* qbase = WSP(unsigned, WS_CTL) + CW_QUEUE + 64 * 8 * ((l * 2 + hb) * 2 + 1);
                  bf16_t* P = WSP(bf16_t, WS_BIG); unsigned char* ob = (unsigned char*)opq(a.out);
                  const int myq = (int)(bar.x & 7u);
                  int qoff = 0, itw;
                  __syncthreads();
                  if (tid == 0) { int it = -1, qq = 0; for (; qq < 8; ++qq) { const int qid = (myq + qq) & 7; const unsigned v = atomicAdd(qbase + 64 * qid, 1u); if (v < 260u) { it = (int)v | (qid << 16); break; } } MISC[4] = (unsigned)it; MISC[5] = (unsigned)qq; }
                  __syncthreads();
                  itw = (int)MISC[4]; qoff = (int)MISC[5];
                  while (itw >= 0) {
                      __syncthreads();
                      unsigned nv = 0u; const bool t0_ = (tid == 0);
                      if (t0_) nv = atomicAdd(qbase + 64 * ((myq + qoff) & 7), 1u);
                      const int item = itw & 0xffff, bl = itw >> 16;
                      mlC_item(lds, P, (bf16_t*)(ob + OB_YB), opq(a.in[7]) + l * 4, opq(a.in[8]) + l * 4, opq(a.in[9]) + (size_t)l * 512, (const bf16_t*)(ob + OB_CB), (const float*)(ob + OB_NB), (const float*)(ob + OB_MB), bl, item / 65, item % 65, tid, lane, wave);
                      if (t0_) { int it = -1, qq = qoff; unsigned v = nv;
                          for (;;) { if (v < 260u) { it = (int)v | (((myq + qq) & 7) << 16); break; } if (++qq >= 8) break; v = atomicAdd(qbase + 64 * ((myq + qq) & 7), 1u); }
                          MISC[4] = (unsigned)it; MISC[5] = (unsigned)qq; }
                      __syncthreads();
                      itw = (int)MISC[4]; qoff = (int)MISC[5];
                  } }
                GRID_BAR(); P_END(18) }
                { P_BEGIN(6) { unsigned char* w_ = opq(a.ws); bf16_t* P = WSP(bf16_t, WS_BIG);
                  const char* yb = (const char*)opq(a.out) + OB_YB;
                  pg8::Gemm gm{yb, nullptr, nullptr, (const char*)(w_ + WS_WBR), (size_t)DM * 512 * 2, LDY, 512, 512, 1024}; pg8::Sched S; S.init(128, DM / 256, 3, G, c);
                  pg8::EpiMerge E{WSP(bf16_t, WS_GT), WSP(bf16_t, WS_Y) + (size_t)hb * MH * DM, MH}; pg8::gemm_phase(lds, gm, S, E, wave);
                  pg8::Gemm gt{yb + (size_t)32768 * LDY * 2, nullptr, nullptr, (const char*)(w_ + WS_WBR), (size_t)DM * 512 * 2, LDY, 512, 512, 1024}; pg8::Sched St; St.init(1, DM / 256, 3, G, (c + G / 2) % G, true);
                  pg8::EpiGateSlab Et{WSP(bf16_t, WS_GT), WSP(float, WS_YT)}; pg8::gemm_phase(lds, gt, St, Et, wave); }
                GRID_BAR();
                { unsigned char* w_ = opq(a.ws); const f32x4* sl = WSP(f32x4, WS_YT); bf16_t* Yh = WSP(bf16_t, WS_Y) + ((size_t)hb * MH + 32768) * DM;
                  int ln = lane; asm volatile("" : "+v"(ln));
                  for (int r = gw; r < MH - 32768; r += NGW) {
#pragma unroll
                      for (int j = 0; j < 4; ++j) { const size_t o = (size_t)r * (DM / 4) + ln + 64 * j; const f32x4 v = sl[o] + sl[o + 256 * DM / 4] + sl[o + 2 * 256 * DM / 4];
                          u32x2 w; w.x = cvt_pk_bf16(v[0], v[1]); w.y = cvt_pk_bf16(v[2], v[3]); ((u32x2*)(Yh + (size_t)r * DM))[ln + 64 * j] = w; } } }
                if (hb == 1 || PROBE_ID) GRID_BAR();
                P_END(6) }
            }
            { P_BEGIN(7) { unsigned char* w_ = opq(a.ws); pg8::Gemm gm{(const char*)(w_ + WS_Y), nullptr, nullptr, (const char*)(w_ + WS_WOUT), 0, DM, DM, DM, 0}; pg8::Sched S; S.init(MT / 256, DM / 256, 1, G, c);
              pg8::EpiBf16 E{(bf16_t*)opq(a.out), DM}; pg8::gemm_phase(lds, gm, S, E, wave);
              pg8::Gemm gt{(const char*)(w_ + WS_Y) + (size_t)MT * DM * 2, nullptr, nullptr, (const char*)(w_ + WS_WOUT), 512, DM, DM, 256, 512}; pg8::Sched St; St.init(1, DM / 256, DM / 256, G, c, true);
              pg8::EpiPartF32 Et{WSP(float, WS_YT), DM}; pg8::gemm_phase(lds, gt, St, Et, wave); }
            GRID_BAR(); P_END(7) }
            { P_BEGIN(8) { unsigned char* w_ = opq(a.ws); hres_t* H = WSP(hres_t, WS_H); const bf16_t* U = (const bf16_t*)opq(a.out); unsigned char* U8 = WSP(unsigned char, WS_U8B); float* SU = WSP(float, WS_SU); const float* g = opq(a.in[2]) + (size_t)l * 6 * DM;
              float* YT = WSP(float, WS_YT);
              norm_pass(U, H, U8, SU, nullptr, g + 3 * DM, g + 4 * DM, 1.0f, gw, NGW, lane);
              for (int r = MT + gw; r < M; r += NGW) norm_row(U + (size_t)r * DM, YT + (size_t)(r - MT) * DM, DM / 256, H + (size_t)r * DM, U8 + (size_t)r * DM, SU + r, nullptr, g + 3 * DM, g + 4 * DM, 1.0f, lane); }
            GRID_BAR(); P_END(8) }
            ++stage;
        }
        if (stage >= DBG_STOP) break;
    }
    { P_BEGIN(20) { unsigned char* w_ = opq(a.ws); const hres_t* H = WSP(hres_t, WS_H); float* out = opq(a.out);
      int ln = lane; asm volatile("" : "+v"(ln));
      for (int r = gw; r < BATCH * SEQ; r += 4 * NGW) {
          h16x4 hv[4][4];
#pragma unroll
          for (int q = 0; q < 4; ++q) { const int rr = r + q * NGW; const int rc = rr < BATCH * SEQ ? rr : r; const int b = rc / SEQ, s = rc - b * SEQ;
              const h16x4* hrow = (const h16x4*)(H + ((size_t)b * T + NMETA + s) * DM);
#pragma unroll
              for (int j = 0; j < 4; ++j) hv[q][j] = hrow[ln + 64 * j]; }
#pragma unroll
          for (int q = 0; q < 4; ++q) { const int rr = r + q * NGW; if (rr < BATCH * SEQ) { f32x4* o = (f32x4*)(out + (size_t)rr * DM) + ln;
#pragma unroll
              for (int j = 0; j < 4; ++j) o[64 * j] = __builtin_convertvector(hv[q][j], f32x4); } } } }
      if (PROBE_ID) GRID_BAR();
      P_END(20) }
#undef WSP
#undef lane
#undef tid
}

extern "C" void kernel_launch(void* const* d_in, const int* in_sizes, int n_in, void* d_out, int out_size, void* d_ws, size_t ws_size, hipStream_t stream) {
    static int grid = 0;
    if (grid == 0) {
        if (n_in != 12 || out_size != BATCH * SEQ * DM || ws_size < WS_END) { fprintf(stderr, "kernel_launch: unexpected shapes (n_in %d, out %d, ws %zu)\n", n_in, out_size, ws_size); grid = -1; return; }
        int dev = 0, cus = 0, per_cu = 0;
        if (hipGetDevice(&dev) != hipSuccess || hipDeviceGetAttribute(&cus, hipDeviceAttributeMultiprocessorCount, dev) != hipSuccess) { grid = -1; return; }
        if (hipFuncSetAttribute((const void*)fwd_kernel, hipFuncAttributeMaxDynamicSharedMemorySize, LDS_BYTES) != hipSuccess) { fprintf(stderr, "kernel_launch: hipFuncSetAttribute failed\n"); grid = -1; return; }
        if (hipOccupancyMaxActiveBlocksPerMultiprocessor(&per_cu, (const void*)fwd_kernel, 512, LDS_BYTES) != hipSuccess || per_cu < 1) { fprintf(stderr, "kernel_launch: occupancy query says %d\n", per_cu); }
        (void)hipGetLastError();
        grid = cus;
    }
    if (grid < 0) return;
    (void)hipMemsetAsync((char*)d_ws + WS_CTL, 0, CTL_ZERO_BYTES, stream);
    Args a{};
    for (int i = 0; i < 12; ++i) a.in[i] = (const float*)d_in[i];
    a.out = (float*)d_out; a.ws = (unsigned char*)d_ws;
    hipLaunchKernelGGL(fwd_kernel, dim3(grid), dim3(512), LDS_BYTES, stream, a);
}
```
